# Optimizing an MI355X kernel written in HIP

```python
import jax, jax.numpy as jnp
from jax import lax
import numpy as np

D_MODEL = 1024
BATCH = 2
SEQ = 8192
DEPTH = 4
DEC_BATCH = 128
DEC_SEQ = 1
PAST_LEN = 8192
PAGE_SIZE = 128

N_A_LAYERS = DEPTH // 2
N_B_LAYERS = DEPTH - N_A_LAYERS
CONV_WIDTH = 3
HEAD_DIM = 64
N_HEADS = D_MODEL // HEAD_DIM
N_KV_HEADS = N_HEADS // 4
GROUP = N_HEADS // N_KV_HEADS
WINDOW = 128
D_FF = -(-8 * D_MODEL // (3 * 256)) * 256
ROPE_THETA = 10000.0
EPS = 1e-6

kernel_name = "yoco_shortconv_swa_sink_decoder_step"


def rmsnorm(x, g):
    xf = x.astype(jnp.float32)
    inv = lax.rsqrt(jnp.mean(xf * xf, axis=-1, keepdims=True) + EPS)
    return (xf * inv).astype(x.dtype) * g


def rope(x, pos):
    half = HEAD_DIM // 2
    freqs = ROPE_THETA ** (-jnp.arange(half, dtype=jnp.float32) / half)
    ang = pos.astype(jnp.float32)[:, None] * freqs[None, :]
    cos = jnp.cos(ang)[:, None, :].astype(x.dtype)
    sin = jnp.sin(ang)[:, None, :].astype(x.dtype)
    x1, x2 = x[..., :half], x[..., half:]
    return jnp.concatenate([x1 * cos - x2 * sin, x2 * cos + x1 * sin], axis=-1)


def short_conv(h, prefix, w_in, conv_w, w_out):
    b, c, xv = jnp.split(h @ w_in, 3, axis=-1)
    u = c * xv
    u_ext = jnp.concatenate([prefix.astype(u.dtype), u], axis=1)
    L = h.shape[1]
    y = conv_w[0] * u_ext[:, 0:L]
    for j in range(1, CONV_WIDTH):
        y = y + conv_w[j] * u_ext[:, j:j + L]
    return (b * y) @ w_out, u_ext[:, -(CONV_WIDTH - 1):]


def swiglu(h, w_gu, w_down):
    g, u = jnp.split(h @ w_gu, 2, axis=-1)
    return (jax.nn.silu(g) * u) @ w_down


def window_attention(q, k, v, sinks, prefix_valid):
    N, Lq = q.shape[0], q.shape[1]
    Lk = k.shape[1]
    qg = q.reshape(N, Lq, N_KV_HEADS, GROUP, HEAD_DIM)
    s = jnp.einsum('nqkgd,nskd->nkgqs', qg, k).astype(jnp.float32) * (HEAD_DIM ** -0.5)
    a = jnp.arange(Lq)[:, None]
    bidx = jnp.arange(Lk)[None, :]
    band = (bidx > a) & (bidx <= a + WINDOW)
    valid = band[None] & ((bidx >= WINDOW)[None] | prefix_valid[:, None, None])
    s = jnp.where(valid[:, None, None], s, -jnp.inf)
    sink = sinks.astype(jnp.float32).reshape(1, N_KV_HEADS, GROUP, 1, 1)
    m = jnp.maximum(jnp.max(s, axis=-1, keepdims=True), sink)
    p = jnp.exp(s - m)
    denom = jnp.sum(p, axis=-1, keepdims=True) + jnp.exp(sink - m)
    o = jnp.einsum('nkgqs,nskd->nqkgd', (p / denom).astype(v.dtype), v)
    return o.reshape(N, Lq, N_HEADS * HEAD_DIM)


def trunk(x, pos, conv_prefix, k_prefix, v_prefix,
          norm_a, w_in_a, conv_w, w_out_a,
          norm_kv, w_kv,
          norm_b, w_q, w_o, sinks,
          norm_ffn, w_gu, w_down, norm_final):
    N, L = x.shape[0], x.shape[1]
    conv_states = []
    for l in range(N_A_LAYERS):
        out, st = short_conv(rmsnorm(x, norm_a[l]), conv_prefix[l], w_in_a[l], conv_w[l], w_out_a[l])
        x = x + out
        x = x + swiglu(rmsnorm(x, norm_ffn[l]), w_gu[l], w_down[l])
        conv_states.append(st)
    conv_states = jnp.stack(conv_states, axis=0)

    k, v = jnp.split(rmsnorm(x, norm_kv) @ w_kv, 2, axis=-1)
    k = rope(k.reshape(N, L, N_KV_HEADS, HEAD_DIM), pos)
    v = v.reshape(N, L, N_KV_HEADS, HEAD_DIM)

    if k_prefix is None:
        nblk = L // WINDOW
        zpad = jnp.zeros((N, WINDOW, N_KV_HEADS, HEAD_DIM), k.dtype)
        def band_keys(t):
            prev = jnp.concatenate([zpad, t[:, :-WINDOW]], axis=1).reshape(N * nblk, WINDOW, N_KV_HEADS, HEAD_DIM)
            cur = t.reshape(N * nblk, WINDOW, N_KV_HEADS, HEAD_DIM)
            return jnp.concatenate([prev, cur], axis=1)
        kb, vb = band_keys(k), band_keys(v)
        prefix_valid = jnp.tile(jnp.arange(nblk) > 0, N)
        k_win, v_win = k[:, -WINDOW:], v[:, -WINDOW:]
    else:
        kb = jnp.concatenate([k_prefix.astype(k.dtype), k], axis=1)
        vb = jnp.concatenate([v_prefix.astype(v.dtype), v], axis=1)
        prefix_valid = jnp.ones((N,), dtype=bool)
        k_win, v_win = kb[:, -WINDOW:], vb[:, -WINDOW:]

    for l in range(N_B_LAYERS):
        h = rmsnorm(x, norm_b[l])
        q = rope((h @ w_q[l]).reshape(N, L, N_HEADS, HEAD_DIM), pos)
        if k_prefix is None:
            qb = q.reshape(N * (L // WINDOW), WINDOW, N_HEADS, HEAD_DIM)
            o = window_attention(qb, kb, vb, sinks[l], prefix_valid).reshape(N, L, N_HEADS * HEAD_DIM)
        else:
            o = window_attention(q, kb, vb, sinks[l], prefix_valid)
        x = x + o @ w_o[l]
        li = N_A_LAYERS + l
        x = x + swiglu(rmsnorm(x, norm_ffn[li]), w_gu[li], w_down[li])
    return rmsnorm(x, norm_final), conv_states, k_win, v_win


def setup_inputs(seed: int = 0) -> dict:
    key = jax.random.key(seed)
    ks = jax.random.split(key, 24)
    f32 = jnp.float32
    D = D_MODEL
    def nrm(k, shape, scale):
        return jax.random.normal(k, shape, f32) * scale
    def gain(k, shape):
        return 1.0 + 0.05 * jax.random.normal(k, shape, f32)
    return {
        "x_prompt": nrm(ks[0], (BATCH, SEQ, D), 1.0),
        "x_sample": nrm(ks[1], (DEC_BATCH, DEC_SEQ, D), 1.0),
        "cache_conv": nrm(ks[2], (N_A_LAYERS, DEC_BATCH, CONV_WIDTH - 1, D), 1.0),
        "cache_k": nrm(ks[3], (DEC_BATCH, WINDOW, N_KV_HEADS, HEAD_DIM), 1.0),
        "cache_v": nrm(ks[4], (DEC_BATCH, WINDOW, N_KV_HEADS, HEAD_DIM), 1.0),
        "norm_a": gain(ks[5], (N_A_LAYERS, D)),
        "w_in_a": nrm(ks[6], (N_A_LAYERS, D, 3 * D), D ** -0.5),
        "conv_w": nrm(ks[7], (N_A_LAYERS, CONV_WIDTH, D), CONV_WIDTH ** -0.5),
        "w_out_a": nrm(ks[8], (N_A_LAYERS, D, D), D ** -0.5),
        "norm_kv": gain(ks[9], (D,)),
        "w_kv": nrm(ks[10], (D, 2 * N_KV_HEADS * HEAD_DIM), D ** -0.5),
        "norm_b": gain(ks[11], (N_B_LAYERS, D)),
        "w_q": nrm(ks[12], (N_B_LAYERS, D, N_HEADS * HEAD_DIM), D ** -0.5),
        "w_o": nrm(ks[13], (N_B_LAYERS, N_HEADS * HEAD_DIM, D), (N_HEADS * HEAD_DIM) ** -0.5),
        "sinks": nrm(ks[14], (N_B_LAYERS, N_HEADS), 0.5),
        "norm_ffn": gain(ks[15], (DEPTH, D)),
        "w_gu": nrm(ks[16], (DEPTH, D, 2 * D_FF), D ** -0.5),
        "w_down": nrm(ks[17], (DEPTH, D_FF, D), D_FF ** -0.5),
        "norm_final": gain(ks[18], (D,)),
    }


def reference(x_prompt, x_sample, cache_conv, cache_k, cache_v,
              norm_a, w_in_a, conv_w, w_out_a, norm_kv, w_kv,
              norm_b, w_q, w_o, sinks, norm_ffn, w_gu, w_down, norm_final):
    B, L = x_prompt.shape[0], x_prompt.shape[1]
    S = x_sample.shape[1]
    pos_prompt = jnp.arange(L, dtype=jnp.int32)
    pos_sample = PAST_LEN + jnp.arange(S, dtype=jnp.int32)
    conv_zero = jnp.zeros((N_A_LAYERS, B, CONV_WIDTH - 1, D_MODEL), x_prompt.dtype)
    y_prompt, conv_prompt, k_win_prompt, v_win_prompt = trunk(
        x_prompt, pos_prompt, conv_zero, None, None,
        norm_a, w_in_a, conv_w, w_out_a, norm_kv, w_kv,
        norm_b, w_q, w_o, sinks, norm_ffn, w_gu, w_down, norm_final)
    y_sample, conv_sample, k_win_sample, v_win_sample = trunk(
        x_sample, pos_sample, cache_conv, cache_k, cache_v,
        norm_a, w_in_a, conv_w, w_out_a, norm_kv, w_kv,
        norm_b, w_q, w_o, sinks, norm_ffn, w_gu, w_down, norm_final)
    return (y_prompt, y_sample, conv_prompt, k_win_prompt, v_win_prompt, conv_sample, k_win_sample, v_win_sample)
```

```cpp
#include <hip/hip_runtime.h>
#include <hip/hip_cooperative_groups.h>
#include <cstdio>
#include <cstdint>
namespace cg = cooperative_groups;

#define LAS __attribute__((address_space(3)))
typedef unsigned short bf16_t;
typedef short bf16x8 __attribute__((ext_vector_type(8)));
typedef float f32x4 __attribute__((ext_vector_type(4)));
typedef float f32x16 __attribute__((ext_vector_type(16)));
typedef unsigned u32x4 __attribute__((ext_vector_type(4)));
typedef unsigned u32x2 __attribute__((ext_vector_type(2)));

constexpr int D = 1024, SEQ = 8192, MP = 16384, MS = 128, MT = MP + MS, MR = MP + 256, FF = 2816;
constexpr int WIN = 128;
constexpr float EPS = 1e-6f;
constexpr float LOG2E = 1.4426950408889634f;
constexpr float QSCALE = 0.125f * LOG2E;

constexpr size_t OUT_Y = 0;
constexpr size_t OUT_CONVP = (size_t)MT * D;
constexpr size_t OUT_KWP = OUT_CONVP + 8192;
constexpr size_t OUT_VWP = OUT_KWP + 65536;
constexpr size_t OUT_CONVS = OUT_VWP + 65536;
constexpr size_t OUT_KWS = OUT_CONVS + 524288;
constexpr size_t OUT_VWS = OUT_KWS + 4194304;
constexpr size_t OUT_TOTAL = OUT_VWS + 4194304;

constexpr size_t WS_WIN = 0;
constexpr size_t SZ_WIN = (size_t)3072 * 1024 * 2;
constexpr size_t WS_WOUT = WS_WIN + 2 * SZ_WIN;
constexpr size_t SZ_SQ = (size_t)1024 * 1024 * 2;
constexpr size_t WS_WGU = WS_WOUT + 2 * SZ_SQ;
constexpr size_t SZ_WGU = (size_t)5632 * 1024 * 2;
constexpr size_t WS_WDN = WS_WGU + 4 * SZ_WGU;
constexpr size_t SZ_WDN = (size_t)1024 * 2816 * 2;
constexpr size_t WS_WKVQ = WS_WDN + 4 * SZ_WDN;
constexpr size_t WS_WQ1 = WS_WKVQ + (size_t)1536 * 1024 * 2;
constexpr size_t WS_WO = WS_WQ1 + SZ_SQ;
constexpr size_t WS_XB = WS_WO + 2 * SZ_SQ;
constexpr size_t SZ_ACT1K = (size_t)MR * 1024 * 2;
constexpr size_t WS_ACT = WS_XB + SZ_ACT1K;
constexpr size_t WS_K = WS_ACT + (size_t)MR * FF * 2;
constexpr size_t WS_VT = WS_K + (size_t)MR * 256 * 2;
constexpr size_t WS_SSQ = WS_VT + (size_t)512 * 8192 * 2;
constexpr size_t WS_COS = WS_SSQ + (size_t)MR * 16 * 4;
constexpr size_t WS_SIN = WS_COS + (size_t)8193 * 32 * 4 + 128;
constexpr size_t WS_BAR = WS_SIN + (size_t)8193 * 32 * 4 + 128;
constexpr size_t WS_END = WS_BAR + 16384;

constexpr int LDS_P0SCR = 64 * 65 * 4;
constexpr int LDS_LINV = 8 * LDS_P0SCR;
constexpr int LDS_BARST = LDS_LINV + 1024;
constexpr int LDS_VSCR = LDS_BARST + 64;
constexpr int LDS_BYTES = LDS_VSCR + 8 * 64 * 48;
#define REP_P0 1
#define REP_ATT 1
#define REP_ACT 1
#define REP_U 1
#define EXTRA_SYNCS 0

__device__ __forceinline__ unsigned cvt_pk_bf16(float lo, float hi) { unsigned r; asm volatile("v_cvt_pk_bf16_f32 %0, %1, %2" : "=v"(r) : "v"(lo), "v"(hi)); return r; }
__device__ __forceinline__ float bf_lo(unsigned w) { return __uint_as_float(w << 16); }
__device__ __forceinline__ float bf_hi(unsigned w) { return __uint_as_float(w & 0xffff0000u); }
__device__ __forceinline__ f32x4 ld_bf4(const bf16_t* p) { const u32x2 w = *(const u32x2*)p; return (f32x4){bf_lo(w.x), bf_hi(w.x), bf_lo(w.y), bf_hi(w.y)}; }
__device__ __forceinline__ void st_bf4(bf16_t* p, f32x4 v) { u32x2 w; w.x = cvt_pk_bf16(v[0], v[1]); w.y = cvt_pk_bf16(v[2], v[3]); *(u32x2*)p = w; }

namespace pg8 {
constexpr int BM = 256, BK = 64, HALF = 128, HTB = HALF * BK * 2, STAGE_BYTES = 8 * HTB, NXCD = 8, WGM = 8;
__device__ __forceinline__ int lds_byte(int r, int c) { const int st = (r >> 4) * 2 + (c >> 5), rr = r & 15, cc = c & 31, ob = rr * 64 + cc * 2; return st * 1024 + (ob ^ (((ob >> 9) & 1) << 5)); }
__device__ __forceinline__ void stage_rc(int b, int& R, int& C) { const int st = b / 1024, sb = b % 1024, swz = sb ^ (((sb >> 9) & 1) << 5); R = (st >> 1) * 16 + swz / 64; C = (st & 1) * 32 + (swz % 64) / 2; }

__device__ __forceinline__ int perm32(int rho) { const int n = rho >> 4, i = rho & 15; return 8 * (i >> 2) + 4 * n + (i & 3); }
struct Unit { int pm, pn; };
struct Gemm { const bf16_t* A; const bf16_t* Bt; int nM, nN, K, b_tile_rows, b_half_rows; };

struct StaticOrder {
    int nM, nN, nwg, G, c;
    __device__ void init(int nM_, int nN_, int G_, int c_) { nM = nM_; nN = nN_; nwg = nM * nN; G = G_; c = c_; }
    __device__ bool next(int i, Unit& u) const {
        const long L = (long)i * G + c; if (L >= nwg) return false;
        int wgid = (int)L; { const int q = nwg / NXCD, r = nwg % NXCD, xcd = wgid % NXCD, off = wgid / NXCD; wgid = (xcd < r ? xcd * (q + 1) : r * (q + 1) + (xcd - r) * q) + off; }
        const int nig = WGM * nN, gid = wgid / nig, fm = gid * WGM, gsz = (nM - fm) < WGM ? (nM - fm) : WGM;
        u.pm = fm + ((wgid % nig) % gsz); u.pn = (wgid % nig) / gsz; return true;
    }
};

template <class Epi>
__device__ __forceinline__ void gemm_phase(LAS unsigned char* lds, const Gemm g, const StaticOrder& S, const Epi& E) {
    int tid_ = threadIdx.x; asm volatile("" : "+v"(tid_));
    const int tid = tid_, wid = __builtin_amdgcn_readfirstlane(tid >> 6), lane = tid & 63, wr = wid >> 2, wc = wid & 3, fr = lane & 15, fq = lane >> 4;
    const int K = g.K, nt = K / BK;
    unsigned voffA[2], voffB[2];
#pragma unroll
    for (int i = 0; i < 2; ++i) { int R, C; stage_rc(tid * 16 + i * 8192, R, C); const int Rp = (R & ~31) + perm32(R & 31);
        const int Rb = (Epi::BMAP == 1) ? ((Rp >> 5) * 64 + (Rp & 31)) : Rp;
        voffA[i] = (unsigned)(R * K + C) * 2u; voffB[i] = (unsigned)(Rb * K + C) * 2u; }
    const size_t kstep = (size_t)(BK * 2);
    const size_t hstepA = (size_t)HALF * K * 2;
    const size_t tstepA = 2 * hstepA;
    const size_t hstepB = (size_t)g.b_half_rows * K * 2;
    const size_t tstepB = (size_t)g.b_tile_rows * K * 2;
    const unsigned ldsw = (unsigned)wid * 1024u;
    const int aoff = lds_byte(wr * 64 + fr, fq * 8), boff = lds_byte(wc * 32 + fr, fq * 8);
#define PG8_SA(b, h) (((b) * 2 + (h)) * HTB)
#define PG8_SB(b, h) ((4 + (b) * 2 + (h)) * HTB)
#define PG8_STAGE(bufoff, gbase, voff) do { _Pragma("unroll") for (int _i = 0; _i < 2; ++_i) \
        __builtin_amdgcn_global_load_lds((const unsigned*)((const char*)(gbase) + (voff)[_i]), (LAS unsigned*)(lds + (bufoff) + ldsw + _i * 8192), 16, 0, 0); } while (0)
#define PG8_LDA(dst, b, h) do { _Pragma("unroll") for (int m = 0; m < 4; ++m) _Pragma("unroll") for (int k = 0; k < 2; ++k) dst[m][k] = *(const LAS bf16x8*)(lds + PG8_SA(b, h) + aoff + m * 2048 + k * 1024); } while (0)
#define PG8_LDB(dst, b, h) do { _Pragma("unroll") for (int n = 0; n < 2; ++n) _Pragma("unroll") for (int k = 0; k < 2; ++k) dst[n][k] = *(const LAS bf16x8*)(lds + PG8_SB(b, h) + boff + n * 2048 + k * 1024); } while (0)
#define PG8_MMA(ai, bj, At, Bt) do { __builtin_amdgcn_s_setprio(1); _Pragma("unroll") for (int m = 0; m < 4; ++m) _Pragma("unroll") for (int n = 0; n < 2; ++n) _Pragma("unroll") for (int k = 0; k < 2; ++k) \
        acc[ai][bj][m][n] = __builtin_amdgcn_mfma_f32_16x16x32_bf16(Bt[n][k], At[m][k], acc[ai][bj][m][n], 0, 0, 0); __builtin_amdgcn_s_setprio(0); } while (0)
#define PG8_WAIT_V(n) asm volatile("s_waitcnt vmcnt(" #n ")" ::: "memory")
#define PG8_WAIT_L(n) asm volatile("s_waitcnt lgkmcnt(" #n ")" ::: "memory")
#define PG8_BAR __builtin_amdgcn_s_barrier()
#define PG8_SCHED __builtin_amdgcn_sched_barrier(0)
    Unit cur, nxt; int ui = 0;
    if (!S.next(0, cur)) return;
    f32x4 acc[2][2][4][2];
#pragma unroll
    for (int a = 0; a < 2; ++a)
#pragma unroll
        for (int b = 0; b < 2; ++b)
#pragma unroll
            for (int m = 0; m < 4; ++m)
#pragma unroll
                for (int n = 0; n < 2; ++n) acc[a][b][m][n] = (f32x4){0.f, 0.f, 0.f, 0.f};
    bf16x8 At[4][2], B0[2][2], B1[2][2];
    const char* cA = (const char*)g.A + (size_t)cur.pm * tstepA; const char* cB = (const char*)g.Bt + (size_t)cur.pn * tstepB;
    PG8_STAGE(PG8_SB(0, 0), cB, voffB); PG8_STAGE(PG8_SB(0, 1), cB + hstepB, voffB); PG8_STAGE(PG8_SA(0, 0), cA, voffA); PG8_STAGE(PG8_SA(0, 1), cA + hstepA, voffA);
    if (wr == 1) PG8_BAR;
    PG8_WAIT_V(2); PG8_BAR;
    PG8_STAGE(PG8_SB(1, 0), cB + kstep, voffB); PG8_STAGE(PG8_SA(1, 0), cA + kstep, voffA); PG8_STAGE(PG8_SB(1, 1), cB + hstepB + kstep, voffB);
    PG8_WAIT_V(6); PG8_BAR;
    for (;;) {
        const bool has_next = S.next(ui + 1, nxt);
        const char* nA = has_next ? (const char*)g.A + (size_t)nxt.pm * tstepA : cA; const char* nB = has_next ? (const char*)g.Bt + (size_t)nxt.pn * tstepB : cB;
        for (int t = 0; t < nt; t += 2) {
            const bool last = (t == nt - 2);
            const char* a1 = cA + (size_t)(t + 1) * kstep;
            const char* a2 = last ? nA : cA + (size_t)(t + 2) * kstep; const char* b2 = last ? nB : cB + (size_t)(t + 2) * kstep;
            const char* a3 = a2 + kstep; const char* b3 = b2 + kstep;
            const bool tail = last && !has_next;
            PG8_LDB(B0, 0, 0); PG8_LDB(B1, 0, 1); PG8_SCHED; PG8_LDA(At, 0, 0); PG8_STAGE(PG8_SA(1, 1), a1 + hstepA, voffA);
            PG8_WAIT_V(8); PG8_WAIT_L(0); PG8_BAR; PG8_MMA(0, 0, At, B0); PG8_MMA(0, 1, At, B1); PG8_BAR; PG8_SCHED;
            PG8_LDA(At, 0, 1);
            if (!tail) { PG8_STAGE(PG8_SB(0, 0), b2, voffB); PG8_STAGE(PG8_SB(0, 1), b2 + hstepB, voffB); PG8_STAGE(PG8_SA(0, 0), a2, voffA); PG8_WAIT_V(8); } else { PG8_WAIT_V(2); }
            PG8_WAIT_L(0); PG8_BAR; PG8_MMA(1, 0, At, B0); PG8_MMA(1, 1, At, B1); PG8_BAR; PG8_SCHED;
            PG8_LDB(B0, 1, 0); PG8_LDB(B1, 1, 1); PG8_SCHED; PG8_LDA(At, 1, 0);
            if (!tail) { PG8_STAGE(PG8_SA(0, 1), a2 + hstepA, voffA); PG8_WAIT_V(8); } else { PG8_WAIT_V(0); }
            PG8_WAIT_L(0); PG8_BAR; PG8_MMA(0, 0, At, B0); PG8_MMA(0, 1, At, B1); PG8_BAR; PG8_SCHED;
            PG8_LDA(At, 1, 1);
            if (!tail) { PG8_STAGE(PG8_SB(1, 0), b3, voffB); PG8_STAGE(PG8_SB(1, 1), b3 + hstepB, voffB); PG8_STAGE(PG8_SA(1, 0), a3, voffA); PG8_WAIT_V(8); }
            PG8_WAIT_L(0); PG8_BAR; PG8_MMA(1, 0, At, B0); PG8_MMA(1, 1, At, B1); PG8_BAR; PG8_SCHED;
        }
        if (wr == 0) PG8_BAR;
        E(acc, cur, wr, wc, fr, fq);
        if (!has_next) break;
#pragma unroll
        for (int a = 0; a < 2; ++a)
#pragma unroll
            for (int b = 0; b < 2; ++b)
#pragma unroll
                for (int m = 0; m < 4; ++m)
#pragma unroll
                    for (int n = 0; n < 2; ++n) acc[a][b][m][n] = (f32x4){0.f, 0.f, 0.f, 0.f};
        cur = nxt; cA = nA; cB = nB; ++ui;
        if (wr == 1) PG8_BAR;
    }
    PG8_WAIT_V(0);
    PG8_BAR;
#undef PG8_SA
#undef PG8_SB
#undef PG8_STAGE
#undef PG8_LDA
#undef PG8_LDB
#undef PG8_MMA
#undef PG8_WAIT_V
#undef PG8_WAIT_L
#undef PG8_BAR
#undef PG8_SCHED
}
}

typedef f32x4 AccT[2][2][4][2];

__device__ __forceinline__ void load_inv(LAS float* linv, const float* ssq, int pm, int wr, int fr, float (&inv)[2][4]) {
    int tid = threadIdx.x; asm volatile("" : "+v"(tid));
    if (tid < 256) {
        const f32x4* p = (const f32x4*)(ssq + (size_t)(pm * 256 + tid) * 16);
        const f32x4 a = p[0], b = p[1], c = p[2], d = p[3];
        const float s = ((a[0] + a[1]) + (a[2] + a[3])) + ((b[0] + b[1]) + (b[2] + b[3])) + ((c[0] + c[1]) + (c[2] + c[3])) + ((d[0] + d[1]) + (d[2] + d[3]));
        linv[tid] = __builtin_amdgcn_rsqf(s * (1.0f / 1024.0f) + EPS);
    }
    asm volatile("s_waitcnt vmcnt(0) lgkmcnt(0)" ::: "memory"); __builtin_amdgcn_s_barrier(); asm volatile("" ::: "memory");
#pragma unroll
    for (int ai = 0; ai < 2; ++ai)
#pragma unroll
        for (int m = 0; m < 4; ++m) inv[ai][m] = linv[ai * 128 + wr * 64 + m * 16 + fr];
    asm volatile("s_waitcnt lgkmcnt(0)" ::: "memory");
}

struct EpiX {
    static constexpr int BMAP = 0; static constexpr bool PAIRED = false, NEEDS_INV = false, HAS_SSQ = true;
    bf16_t* xb; float* ssq;
    __device__ __forceinline__ float elem(int row, int col0, f32x4 a) const {
        bf16_t* p = xb + (size_t)row * D + col0; const f32x4 o = ld_bf4(p) + a; st_bf4(p, o);
        return (o[0] * o[0] + o[1] * o[1]) + (o[2] * o[2] + o[3] * o[3]);
    }
    __device__ __forceinline__ void operator()(const AccT& acc, const pg8::Unit& u, int wr, int wc, int fr, int fq) const {
        const int row0 = u.pm * 256 + wr * 64 + fr, col0 = u.pn * 256 + wc * 32 + 8 * fq;
        u32x4 xi[2][4][2];
#pragma unroll
        for (int ai = 0; ai < 2; ++ai)
#pragma unroll
            for (int m = 0; m < 4; ++m)
#pragma unroll
                for (int bj = 0; bj < 2; ++bj) xi[ai][m][bj] = *(const u32x4*)(xb + (size_t)(row0 + ai * 128 + m * 16) * D + col0 + bj * 128);
#pragma unroll
        for (int ai = 0; ai < 2; ++ai)
#pragma unroll
            for (int m = 0; m < 4; ++m) {
                const int row = row0 + ai * 128 + m * 16; float ss = 0.f;
#pragma unroll
                for (int bj = 0; bj < 2; ++bj) { const u32x4 w = xi[ai][m][bj];
                    const f32x4 o0 = (f32x4){bf_lo(w.x), bf_hi(w.x), bf_lo(w.y), bf_hi(w.y)} + acc[ai][bj][m][0];
                    const f32x4 o1 = (f32x4){bf_lo(w.z), bf_hi(w.z), bf_lo(w.w), bf_hi(w.w)} + acc[ai][bj][m][1];
                    u32x4 p; p.x = cvt_pk_bf16(o0[0], o0[1]); p.y = cvt_pk_bf16(o0[2], o0[3]); p.z = cvt_pk_bf16(o1[0], o1[1]); p.w = cvt_pk_bf16(o1[2], o1[3]);
                    *(u32x4*)(xb + (size_t)row * D + col0 + bj * 128) = p;
                    ss += ((o0[0] * o0[0] + o0[1] * o0[1]) + (o0[2] * o0[2] + o0[3] * o0[3])) + ((o1[0] * o1[0] + o1[1] * o1[1]) + (o1[2] * o1[2] + o1[3] * o1[3])); }
                ss += __shfl_xor(ss, 16); ss += __shfl_xor(ss, 32);
                if (fq == 0) ssq[(size_t)row * 16 + u.pn * 4 + wc] = ss;
            }
    }
    __device__ __forceinline__ float mini(int row, int cb, int c4, f32x4 v0, f32x4 v1, float) const { return elem(row, cb * 64 + c4, v0) + elem(row, cb * 64 + 32 + c4, v1); }
};

struct EpiU {
    static constexpr int BMAP = 0; static constexpr bool PAIRED = true, NEEDS_INV = true, HAS_SSQ = false;
    LAS float* linv; bf16_t* ub; const float* ssq; float* convp; float* convs; bf16_t* zb; const float* cw; const float* cache;
    __device__ __forceinline__ void elem(int row, int j0, f32x4 c, f32x4 xv, float i2) const {
        const f32x4 v = c * xv * i2;
        st_bf4(ub + (size_t)row * D + j0, v);
        if (row < MP) { const int t = row & (SEQ - 1); if (t >= SEQ - 2) *(f32x4*)(convp + ((size_t)((row >> 13) * 2 + (t - (SEQ - 2))) * D + j0)) = v; }
        else { *(f32x4*)(convs + ((size_t)((row - MP) * 2 + 1) * D + j0)) = v; }
    }
    __device__ __forceinline__ void operator()(const AccT& acc, const pg8::Unit& u, int wr, int wc, int fr, int fq) const {
        const int row0 = u.pm * 256 + wr * 64 + fr, j00 = u.pn * 128 + wc * 32 + 8 * fq;
        float inv[2][4]; load_inv(linv, ssq, u.pm, wr, fr, inv);
#pragma unroll
        for (int ai = 0; ai < 2; ++ai)
#pragma unroll
            for (int m = 0; m < 4; ++m) {
                const int row = row0 + ai * 128 + m * 16; const float i2 = inv[ai][m] * inv[ai][m];
                { const f32x4 v0 = acc[ai][0][m][0] * acc[ai][1][m][0] * i2, v1 = acc[ai][0][m][1] * acc[ai][1][m][1] * i2;
                  u32x4 p; p.x = cvt_pk_bf16(v0[0], v0[1]); p.y = cvt_pk_bf16(v0[2], v0[3]); p.z = cvt_pk_bf16(v1[0], v1[1]); p.w = cvt_pk_bf16(v1[2], v1[3]);
                  *(u32x4*)(ub + (size_t)row * D + j00) = p;
                  const int t = row & (SEQ - 1);
                  if (t >= SEQ - 2) { float* cp = convp + ((size_t)((row >> 13) * 2 + (t - (SEQ - 2))) * D + j00); *(f32x4*)cp = v0; *(f32x4*)(cp + 4) = v1; } }
                asm volatile("" ::: "memory");
            }
    }
    __device__ __forceinline__ float mini(int row, int cb, int c4, f32x4 v0, f32x4 v1, float iv) const { elem(row, cb * 32 + c4, v0, v1, iv * iv); return 0.f; }
    __device__ __forceinline__ float mini3(int row, int cb, int c4, f32x4 vc, f32x4 vxv, f32x4 vb, float iv) const {
        const int j0 = cb * 32 + c4, nn = row - MP;
        const f32x4 uu = vc * vxv * (iv * iv);
        *(f32x4*)(convs + ((size_t)(nn * 2 + 1) * D + j0)) = uu;
        const f32x4 w0 = *(const f32x4*)(cw + j0), w1 = *(const f32x4*)(cw + D + j0), w2 = *(const f32x4*)(cw + 2 * D + j0);
        const f32x4 u1 = *(const f32x4*)(cache + (size_t)(nn * 2 + 1) * D + j0), u2 = *(const f32x4*)(cache + (size_t)(nn * 2) * D + j0);
        st_bf4(zb + (size_t)row * D + j0, (vb * iv) * (w0 * u2 + w1 * u1 + w2 * uu));
        return 0.f;
    }
};

struct EpiZ {
    static constexpr int BMAP = 0; static constexpr bool PAIRED = false, NEEDS_INV = true, HAS_SSQ = false;
    LAS float* linv; bf16_t* zb; const bf16_t* ub; const float* ssq; const float* cw; const float* cache;
    __device__ __forceinline__ void operator()(const AccT& acc, const pg8::Unit& u, int wr, int wc, int fr, int fq) const {
        const int row0 = u.pm * 256 + wr * 64 + fr, col00 = u.pn * 256 + wc * 32 + 8 * fq;
        float inv[2][4]; load_inv(linv, ssq, u.pm, wr, fr, inv);
        const int lane = fq * 16 + fr, l1 = lane - 1, l2 = lane - 2, l15 = fq * 16 + 15, l14 = fq * 16 + 14;
#pragma unroll
        for (int bj = 0; bj < 2; ++bj) { u32x2 zlo[2][4];
#pragma unroll
            for (int n = 0; n < 2; ++n) { const int col0 = col00 + bj * 128 + n * 4;
                u32x2 u0[2][4], hA[2], hB[2];
#pragma unroll
                for (int ai = 0; ai < 2; ++ai) {
                    const int rb = u.pm * 256 + ai * 128 + wr * 64;
                    const int ra = (rb & (SEQ - 1)) >= 1 ? rb - 1 : rb, rbb = (rb & (SEQ - 1)) >= 2 ? rb - 2 : rb;
                    hA[ai] = *(const u32x2*)(ub + (size_t)ra * D + col0); hB[ai] = *(const u32x2*)(ub + (size_t)rbb * D + col0);
#pragma unroll
                    for (int m = 0; m < 4; ++m) u0[ai][m] = *(const u32x2*)(ub + (size_t)(row0 + ai * 128 + m * 16) * D + col0); }
                const f32x4 w0 = *(const f32x4*)(cw + col0), w1 = *(const f32x4*)(cw + D + col0), w2 = *(const f32x4*)(cw + 2 * D + col0);
#pragma unroll
                for (int ai = 0; ai < 2; ++ai)
#pragma unroll
                    for (int m = 0; m < 4; ++m) { const int row = row0 + ai * 128 + m * 16; const int t = row & (SEQ - 1);
                        const u32x2 c0 = u0[ai][m];
                        u32x2 a1, a2, p15, p14;
                        a1.x = (unsigned)__shfl((int)c0.x, l1); a1.y = (unsigned)__shfl((int)c0.y, l1);
                        a2.x = (unsigned)__shfl((int)c0.x, l2); a2.y = (unsigned)__shfl((int)c0.y, l2);
                        if (m == 0) { p15 = hA[ai]; p14 = hB[ai]; }
                        else { const u32x2 pv = u0[ai][m - 1];
                            p15.x = (unsigned)__shfl((int)pv.x, l15); p15.y = (unsigned)__shfl((int)pv.y, l15);
                            p14.x = (unsigned)__shfl((int)pv.x, l14); p14.y = (unsigned)__shfl((int)pv.y, l14); }
                        const u32x2 b1 = (fr >= 1) ? a1 : p15;
                        const u32x2 b2 = (fr >= 2) ? a2 : ((fr == 1) ? p15 : p14);
                        const f32x4 x0 = (f32x4){bf_lo(c0.x), bf_hi(c0.x), bf_lo(c0.y), bf_hi(c0.y)};
                        f32x4 x1 = (f32x4){bf_lo(b1.x), bf_hi(b1.x), bf_lo(b1.y), bf_hi(b1.y)}, x2 = (f32x4){bf_lo(b2.x), bf_hi(b2.x), bf_lo(b2.y), bf_hi(b2.y)};
                        if (t < 1) x1 = (f32x4){0.f, 0.f, 0.f, 0.f};
                        if (t < 2) x2 = (f32x4){0.f, 0.f, 0.f, 0.f};
                        const f32x4 y = w0 * x2 + w1 * x1 + w2 * x0;
                        const f32x4 zz = (acc[ai][bj][m][n] * inv[ai][m]) * y; u32x2 zw; zw.x = cvt_pk_bf16(zz[0], zz[1]); zw.y = cvt_pk_bf16(zz[2], zz[3]);
                        if (n == 0) zlo[ai][m] = zw;
                        else { u32x4 p; p.x = zlo[ai][m].x; p.y = zlo[ai][m].y; p.z = zw.x; p.w = zw.y; *(u32x4*)(zb + (size_t)row * D + col0 - 4) = p; } }
                asm volatile("" ::: "memory");
            } }
    }
};

struct EpiAct {
    static constexpr int BMAP = 0; static constexpr bool PAIRED = true, NEEDS_INV = true, HAS_SSQ = false;
    LAS float* linv; bf16_t* act; const float* ssq;
    __device__ __forceinline__ void elem(int row, int j0, f32x4 ga, f32x4 ua, float iv) const {
        const f32x4 gg = ga * iv, uu = ua * iv; f32x4 o;
#pragma unroll
        for (int e = 0; e < 4; ++e) { const float sg = __builtin_amdgcn_rcpf(1.0f + __builtin_amdgcn_exp2f(-gg[e] * LOG2E)); o[e] = gg[e] * sg * uu[e]; }
        st_bf4(act + (size_t)row * FF + j0, o);
    }
    __device__ __forceinline__ void operator()(const AccT& acc, const pg8::Unit& u, int wr, int wc, int fr, int fq) const {
        const int row0 = u.pm * 256 + wr * 64 + fr, j00 = u.pn * 128 + wc * 32 + 8 * fq;
        float inv[2][4]; load_inv(linv, ssq, u.pm, wr, fr, inv);
#pragma unroll
        for (int ai = 0; ai < 2; ++ai)
#pragma unroll
            for (int m = 0; m < 4; ++m) {
                const int row = row0 + ai * 128 + m * 16;
                { const float iv = inv[ai][m]; f32x4 o[2];
#pragma unroll
                  for (int n = 0; n < 2; ++n) { const f32x4 gg = acc[ai][0][m][n] * iv, uu = acc[ai][1][m][n] * iv;
#pragma unroll
                      for (int e = 0; e < 4; ++e) { const float sg = __builtin_amdgcn_rcpf(1.0f + __builtin_amdgcn_exp2f(-gg[e] * LOG2E)); o[n][e] = gg[e] * sg * uu[e]; } }
                  u32x4 p; p.x = cvt_pk_bf16(o[0][0], o[0][1]); p.y = cvt_pk_bf16(o[0][2], o[0][3]); p.z = cvt_pk_bf16(o[1][0], o[1][1]); p.w = cvt_pk_bf16(o[1][2], o[1][3]);
                  *(u32x4*)(act + (size_t)row * FF + j00) = p; }
                asm volatile("" ::: "memory");
            }
    }
    __device__ __forceinline__ float mini(int row, int cb, int c4, f32x4 v0, f32x4 v1, float iv) const { elem(row, cb * 32 + c4, v0, v1, iv); return 0.f; }
};

struct EpiKVQ {
    static constexpr int BMAP = 1; static constexpr bool PAIRED = false, NEEDS_INV = true, HAS_SSQ = false;
    LAS float* linv; const float* ssq; const float* cosT; const float* sinT; bf16_t* kb; bf16_t* vT; bf16_t* qb; float* out; int pn_k, pn_v, pn_q0; LAS unsigned char* vscr;
    __device__ __forceinline__ void elemV(int row, int hh, int d0, f32x4 a, float iv) const {
        const f32x4 v = a * iv;
        if (row < MP) { const int b = row >> 13, t = row & (SEQ - 1);
            bf16_t* vp = vT + ((size_t)((b * 4 + hh) * 64 + d0)) * SEQ + t;
            const unsigned w01 = cvt_pk_bf16(v[0], v[1]), w23 = cvt_pk_bf16(v[2], v[3]);
            vp[0] = (bf16_t)(w01 & 0xffffu); vp[SEQ] = (bf16_t)(w01 >> 16); vp[2 * SEQ] = (bf16_t)(w23 & 0xffffu); vp[3 * SEQ] = (bf16_t)(w23 >> 16);
            if (t >= SEQ - WIN) *(f32x4*)(out + OUT_VWP + ((size_t)((b * WIN + t - (SEQ - WIN)) * 4 + hh) * 64 + d0)) = v; }
        else if (row < MT) { *(f32x4*)(out + OUT_VWS + ((size_t)(((row - MP) * WIN + (WIN - 1)) * 4 + hh) * 64 + d0)) = v; }
    }
    __device__ __forceinline__ void elemR(int row, int head, int dlo, f32x4 a1, f32x4 a2, float iv, bool isk) const {
        const int pos = (row < MP) ? (row & (SEQ - 1)) : SEQ;
        const f32x4 c = *(const f32x4*)(cosT + (size_t)pos * 32 + dlo), s = *(const f32x4*)(sinT + (size_t)pos * 32 + dlo);
        const f32x4 x1 = a1 * iv, x2 = a2 * iv;
        const f32x4 r1 = x1 * c - x2 * s, r2 = x2 * c + x1 * s;
        if (isk) {
            st_bf4(kb + (size_t)row * 256 + head * 64 + dlo, r1); st_bf4(kb + (size_t)row * 256 + head * 64 + 32 + dlo, r2);
            if (row < MP) { const int b = row >> 13, t = row & (SEQ - 1);
                if (t >= SEQ - WIN) { float* o = out + OUT_KWP + ((size_t)((b * WIN + t - (SEQ - WIN)) * 4 + head) * 64 + dlo); *(f32x4*)o = r1; *(f32x4*)(o + 32) = r2; } }
            else if (row < MT) { float* o = out + OUT_KWS + ((size_t)(((row - MP) * WIN + (WIN - 1)) * 4 + head) * 64 + dlo); *(f32x4*)o = r1; *(f32x4*)(o + 32) = r2; }
        } else {
            st_bf4(qb + (size_t)row * D + head * 64 + dlo, r1 * QSCALE); st_bf4(qb + (size_t)row * D + head * 64 + 32 + dlo, r2 * QSCALE);
        }
    }
    __device__ __forceinline__ void operator()(const AccT& acc, const pg8::Unit& u, int wr, int wc, int fr, int fq) const {
        const int row0 = u.pm * 256 + wr * 64 + fr;
        float inv[2][4]; load_inv(linv, ssq, u.pm, wr, fr, inv);
        if (u.pn == pn_v) {
            if (u.pm * 256 < MP) {
                LAS unsigned char* scr = vscr + (wr * 4 + wc) * (64 * 48);
                const int lane = fq * 16 + fr;
#pragma unroll
                for (int ai = 0; ai < 2; ++ai)
#pragma unroll
                    for (int m = 0; m < 4; ++m) {
                        const int row = row0 + ai * 128 + m * 16; const float iv = inv[ai][m]; const int b = row >> 13, t = row & (SEQ - 1);
#pragma unroll
                        for (int bj = 0; bj < 2; ++bj)
#pragma unroll
                            for (int n = 0; n < 2; ++n) { const int d0 = 32 * bj + 8 * fq + 4 * n; const f32x4 v = acc[ai][bj][m][n] * iv;
                                const unsigned w01 = cvt_pk_bf16(v[0], v[1]), w23 = cvt_pk_bf16(v[2], v[3]);
                                LAS unsigned short* sp = (LAS unsigned short*)(scr + d0 * 48 + fr * 2);
                                sp[0] = (unsigned short)(w01 & 0xffffu); sp[24] = (unsigned short)(w01 >> 16); sp[48] = (unsigned short)(w23 & 0xffffu); sp[72] = (unsigned short)(w23 >> 16);
                                if (t >= SEQ - WIN) *(f32x4*)(out + OUT_VWP + ((size_t)((b * WIN + t - (SEQ - WIN)) * 4 + wc) * 64 + d0)) = v; }
                        asm volatile("s_waitcnt lgkmcnt(0)" ::: "memory");
                        const u32x4 q0 = *(const LAS u32x4*)(scr + lane * 48), q1 = *(const LAS u32x4*)(scr + lane * 48 + 16);
                        asm volatile("s_waitcnt lgkmcnt(0)" ::: "memory");
                        const int t0 = (u.pm * 256 + ai * 128 + wr * 64 + m * 16) & (SEQ - 1);
                        bf16_t* vp = vT + ((size_t)((b * 4 + wc) * 64 + lane)) * SEQ + t0;
                        *(u32x4*)vp = q0; *(u32x4*)(vp + 8) = q1;
                    }
            } else {
#pragma unroll
                for (int ai = 0; ai < 2; ++ai)
#pragma unroll
                    for (int m = 0; m < 4; ++m) {
                        const int row = row0 + ai * 128 + m * 16;
#pragma unroll
                        for (int bj = 0; bj < 2; ++bj)
#pragma unroll
                            for (int n = 0; n < 2; ++n) elemV(row, wc, 32 * bj + 4 * n + 8 * fq, acc[ai][bj][m][n], inv[ai][m]);
                        asm volatile("" ::: "memory");
                    }
            }
        } else {
            const bool isk = (u.pn == pn_k); const int head = isk ? wc : (u.pn - pn_q0) * 4 + wc;
#pragma unroll
            for (int ai = 0; ai < 2; ++ai)
#pragma unroll
                for (int m = 0; m < 4; ++m) {
                    const int row = row0 + ai * 128 + m * 16; int fql = fq; asm volatile("" : "+v"(fql));
                    const int dlo = 8 * fql, pos = (row < MP) ? (row & (SEQ - 1)) : SEQ; const float iv = inv[ai][m];
                    f32x4 r1[2], r2[2];
#pragma unroll
                    for (int n = 0; n < 2; ++n) { const f32x4 c = *(const f32x4*)(cosT + (size_t)pos * 32 + dlo + 4 * n), sn = *(const f32x4*)(sinT + (size_t)pos * 32 + dlo + 4 * n);
                        const f32x4 x1 = acc[ai][0][m][n] * iv, x2 = acc[ai][1][m][n] * iv; r1[n] = x1 * c - x2 * sn; r2[n] = x2 * c + x1 * sn; }
                    if (isk) {
                        u32x4 p1, p2; p1.x = cvt_pk_bf16(r1[0][0], r1[0][1]); p1.y = cvt_pk_bf16(r1[0][2], r1[0][3]); p1.z = cvt_pk_bf16(r1[1][0], r1[1][1]); p1.w = cvt_pk_bf16(r1[1][2], r1[1][3]);
                        p2.x = cvt_pk_bf16(r2[0][0], r2[0][1]); p2.y = cvt_pk_bf16(r2[0][2], r2[0][3]); p2.z = cvt_pk_bf16(r2[1][0], r2[1][1]); p2.w = cvt_pk_bf16(r2[1][2], r2[1][3]);
                        *(u32x4*)(kb + (size_t)row * 256 + head * 64 + dlo) = p1; *(u32x4*)(kb + (size_t)row * 256 + head * 64 + 32 + dlo) = p2;
                        float* o = nullptr;
                        if (row < MP) { const int b = row >> 13, t = row & (SEQ - 1); if (t >= SEQ - WIN) o = out + OUT_KWP + ((size_t)((b * WIN + t - (SEQ - WIN)) * 4 + head) * 64 + dlo); }
                        else if (row < MT) o = out + OUT_KWS + ((size_t)(((row - MP) * WIN + (WIN - 1)) * 4 + head) * 64 + dlo);
                        if (o) { *(f32x4*)o = r1[0]; *(f32x4*)(o + 4) = r1[1]; *(f32x4*)(o + 32) = r2[0]; *(f32x4*)(o + 36) = r2[1]; }
                    } else {
                        u32x4 p1, p2; p1.x = cvt_pk_bf16(r1[0][0] * QSCALE, r1[0][1] * QSCALE); p1.y = cvt_pk_bf16(r1[0][2] * QSCALE, r1[0][3] * QSCALE); p1.z = cvt_pk_bf16(r1[1][0] * QSCALE, r1[1][1] * QSCALE); p1.w = cvt_pk_bf16(r1[1][2] * QSCALE, r1[1][3] * QSCALE);
                        p2.x = cvt_pk_bf16(r2[0][0] * QSCALE, r2[0][1] * QSCALE); p2.y = cvt_pk_bf16(r2[0][2] * QSCALE, r2[0][3] * QSCALE); p2.z = cvt_pk_bf16(r2[1][0] * QSCALE, r2[1][1] * QSCALE); p2.w = cvt_pk_bf16(r2[1][2] * QSCALE, r2[1][3] * QSCALE);
                        *(u32x4*)(qb + (size_t)row * D + head * 64 + dlo) = p1; *(u32x4*)(qb + (size_t)row * D + head * 64 + 32 + dlo) = p2;
                    }
                    asm volatile("" ::: "memory");
                }
        }
    }
    __device__ __forceinline__ float mini(int row, int cb, int c4, f32x4 v0, f32x4 v1, float iv) const {
        if (pn_k >= 0 && cb >= 4 && cb < 8) { elemV(row, cb - 4, c4, v0, iv); elemV(row, cb - 4, 32 + c4, v1, iv); }
        else { const bool isk = (pn_k >= 0 && cb < 4); const int head = isk ? cb : (pn_k >= 0 ? cb - 8 : cb); elemR(row, head, c4, v0, v1, iv, isk); }
        return 0.f;
    }
};

template <class Epi, int NP>
__device__ __forceinline__ void mini_phase(LAS unsigned char* lds, const bf16_t* A, const bf16_t* Bt, int K, int pb1, int pb2, int mstr, int ncb, const Epi& E, const float* ssq_in, int bi, int nblk) {
    int tid_ = threadIdx.x; asm volatile("" : "+v"(tid_));
    const int wid = __builtin_amdgcn_readfirstlane(tid_ >> 6), lane = tid_ & 63, ql = lane & 31, hi = lane >> 5;
    const int kw = K >> 3, nst = kw >> 4;
    LAS float* part = (LAS float*)lds;
    for (int task = bi; task < 4 * ncb; task += nblk) {
        const int rb = task & 3, cb = task >> 2;
        const int row = MP + rb * 32 + 8 * (wid & 3) + (lane >> 3), c4 = 4 * (lane & 7);
        float sq = 0.f;
        if (Epi::NEEDS_INV && wid < 4) {
            const f32x4* p = (const f32x4*)(ssq_in + (size_t)row * 16);
            const f32x4 a = p[0], b = p[1], c = p[2], d = p[3];
            sq = ((a[0] + a[1]) + (a[2] + a[3])) + ((b[0] + b[1]) + (b[2] + b[3])) + ((c[0] + c[1]) + (c[2] + c[3])) + ((d[0] + d[1]) + (d[2] + d[3]));
        }
        const bf16_t* ap = A + (size_t)(MP + rb * 32 + ql) * K + wid * kw + hi * 8;
        const bf16_t* b0p = Bt + (size_t)(cb * mstr + ql) * K + wid * kw + hi * 8;
        const bf16_t* b1p = b0p + (long)pb1 * K;
        const bf16_t* b2p = b0p + (long)pb2 * K;
        f32x16 a0, a1, a2;
#pragma unroll
        for (int r = 0; r < 16; ++r) { a0[r] = 0.f; a1[r] = 0.f; a2[r] = 0.f; }
#pragma unroll 8
        for (int s = 0; s < nst; ++s) {
            const bf16x8 av = *(const bf16x8*)(ap + s * 16), w0 = *(const bf16x8*)(b0p + s * 16), w1 = *(const bf16x8*)(b1p + s * 16);
            a0 = __builtin_amdgcn_mfma_f32_32x32x16_bf16(w0, av, a0, 0, 0, 0);
            a1 = __builtin_amdgcn_mfma_f32_32x32x16_bf16(w1, av, a1, 0, 0, 0);
            if (NP == 3) { const bf16x8 w2 = *(const bf16x8*)(b2p + s * 16); a2 = __builtin_amdgcn_mfma_f32_32x32x16_bf16(w2, av, a2, 0, 0, 0); }
        }
#pragma unroll
        for (int r = 0; r < 16; ++r) { part[((wid * NP + 0) * 16 + r) * 65 + lane] = a0[r]; part[((wid * NP + 1) * 16 + r) * 65 + lane] = a1[r];
            if (NP == 3) part[((wid * NP + 2) * 16 + r) * 65 + lane] = a2[r]; }
        __syncthreads();
        if (wid < 4) {
            const int rsel = 4 * (c4 >> 3), lsel = 8 * wid + (lane >> 3) + 32 * ((c4 >> 2) & 1);
            f32x4 v[3];
#pragma unroll
            for (int p = 0; p < NP; ++p) { v[p] = (f32x4){0.f, 0.f, 0.f, 0.f};
#pragma unroll
                for (int w = 0; w < 8; ++w)
#pragma unroll
                    for (int e = 0; e < 4; ++e) v[p][e] += part[((w * NP + p) * 16 + rsel + e) * 65 + lsel]; }
            const float iv = Epi::NEEDS_INV ? __builtin_amdgcn_rsqf(sq * (1.0f / 1024.0f) + EPS) : 1.f;
            float ss;
            if constexpr (NP == 3) ss = E.mini3(row, cb, c4, v[0], v[1], v[2], iv); else ss = E.mini(row, cb, c4, v[0], v[1], iv);
            if (Epi::HAS_SSQ) { ss += __shfl_xor(ss, 1); ss += __shfl_xor(ss, 2); ss += __shfl_xor(ss, 4);
                if ((lane & 7) == 0) ((float*)ssq_in)[(size_t)row * 16 + cb] = ss; }
        }
        __syncthreads();
    }
}

#define XB_TMO      128
#define XB_XCNT(j)  (256  + 64 * (j))
#define XB_XSUB(j)  (1280 + 64 * (j))
#define XB_XGEN(j)  (2304 + 64 * (j))
#define XB_TOP      3328
#define XB_TOPGEN   3392
#define XCD_BAR_WORDS 3456
#define XB_SPIN_CAP (1u << 18)
__device__ __forceinline__ unsigned xb_ld(unsigned* p)              { return __hip_atomic_load(p, __ATOMIC_RELAXED, __HIP_MEMORY_SCOPE_AGENT); }
__device__ __forceinline__ unsigned xb_add(unsigned* p, unsigned v) { return __hip_atomic_fetch_add(p, v, __ATOMIC_RELAXED, __HIP_MEMORY_SCOPE_AGENT); }
__device__ __forceinline__ unsigned xb_xcc_id() { return (unsigned)__builtin_amdgcn_s_getreg((3 << 11) | 20) & 0xFu; }
#define XB_SPIN(cond, bar) do { unsigned _sp = 0; while (cond) { __builtin_amdgcn_s_sleep(1); \
    if ((++_sp & 255u) == 0u) { if (xb_ld(&(bar)[XB_TMO])) break; if (_sp > XB_SPIN_CAP) { atomicAdd(&(bar)[XB_TMO], 1u); break; } } } } while (0)
struct XcdBarrier { unsigned* bar; unsigned x; volatile LAS unsigned* st; };
__device__ __forceinline__ XcdBarrier xcd_barrier_post(unsigned* bar, volatile LAS unsigned* st) {
    XcdBarrier b; b.bar = bar; b.x = (unsigned)__builtin_amdgcn_readfirstlane((int)xb_xcc_id()); b.st = st;
    if (threadIdx.x == 0) (void)xb_add(&bar[XB_XCNT(b.x)], 1u);
    return b;
}
__device__ __forceinline__ void xcd_barrier_complete(unsigned* bar, unsigned x, unsigned& nloc, unsigned& nx) {
    const unsigned G = gridDim.x * gridDim.y * gridDim.z;
    unsigned sum, cnt, mine, sp = 0u;
    for (;;) {
        sum = 0u; cnt = 0u; mine = 0u;
#pragma unroll
        for (unsigned j = 0; j < 16; ++j) { const unsigned c = xb_ld(&bar[XB_XCNT(j)]); sum += c; cnt += (c > 0u) ? 1u : 0u; mine = (j == x) ? c : mine; }
        if (sum == G) break;
        __builtin_amdgcn_s_sleep(1);
        if ((++sp & 255u) == 0u) { if (xb_ld(&bar[XB_TMO])) break; if (sp > XB_SPIN_CAP) { atomicAdd(&bar[XB_TMO], 1u); break; } }
    }
    nloc = mine > 0u ? mine : 1u; nx = cnt > 0u ? cnt : 1u;
}
__device__ __forceinline__ void xcd_barrier(const XcdBarrier& b) {
    asm volatile("s_waitcnt vmcnt(0)" ::: "memory");
    __syncthreads();
    if (threadIdx.x == 0) {
        unsigned* bar = b.bar;
        __builtin_amdgcn_s_waitcnt(0);
        unsigned bx = b.x; asm volatile("" : "+s"(bx));
        unsigned nloc = b.st[0], nx = b.st[1];
        if (nloc == 0u) { xcd_barrier_complete(bar, bx, nloc, nx); b.st[0] = nloc; b.st[1] = nx; }
        const unsigned old = xb_add(&bar[XB_XSUB(bx)], 1u);
        const unsigned gen = old / nloc;
        if (old + 1u == (gen + 1u) * nloc) {
            __builtin_amdgcn_fence(__ATOMIC_RELEASE, "agent");
            asm volatile("s_waitcnt vmcnt(0)" ::: "memory");
            const unsigned og = xb_add(&bar[XB_TOP], 1u);
            const unsigned tg = og / nx;
            if (og + 1u == (tg + 1u) * nx) xb_add(&bar[XB_TOPGEN], 1u);
            else XB_SPIN(xb_ld(&bar[XB_TOPGEN]) == tg, bar);
            __builtin_amdgcn_fence(__ATOMIC_ACQUIRE, "agent");
            xb_add(&bar[XB_XGEN(bx)], 1u);
            asm volatile("s_waitcnt vmcnt(0)" ::: "memory");
        } else {
            XB_SPIN(xb_ld(&bar[XB_XGEN(bx)]) == gen, bar);
            __builtin_amdgcn_fence(__ATOMIC_ACQUIRE, "agent");
            asm volatile("s_waitcnt vmcnt(0)" ::: "memory");
        }
    }
    __syncthreads();
}

__device__ __forceinline__ unsigned f2bf(float f) { unsigned u = __builtin_bit_cast(unsigned, f); return (u + 0x7fffu + ((u >> 16) & 1u)) >> 16; }
__device__ __forceinline__ unsigned pk2(float lo, float hi) { return f2bf(lo) | (f2bf(hi) << 16); }
__device__ __forceinline__ void p0_transpose_item(const float* W, const float* gain, int K, int N, bf16_t* WT, int row_off, LAS float* scr, int item, int lane) {
    const int nblk = N / 64, kb = item / nblk, nb = item % nblk, k0 = 64 * kb, n0 = 64 * nb;
    const int ksub = lane >> 4, n4 = (lane & 15) * 4;
    f32x4 v[16];
#pragma unroll
    for (int i = 0; i < 16; ++i) v[i] = *(const f32x4*)(W + (size_t)(k0 + 4 * i + ksub) * N + n0 + n4);
#pragma unroll
    for (int i = 0; i < 16; ++i) { const int kk = 4 * i + ksub; const float gsc = gain ? gain[k0 + kk] : 1.0f; LAS float* d = scr + kk * 65 + n4;
        d[0] = v[i][0] * gsc; d[1] = v[i][1] * gsc; d[2] = v[i][2] * gsc; d[3] = v[i][3] * gsc; }
    asm volatile("s_waitcnt lgkmcnt(0)" ::: "memory");
    const int c = lane & 7;
#pragma unroll
    for (int j = 0; j < 8; ++j) { const int n = (lane >> 3) + 8 * j; const LAS float* s = scr + (8 * c) * 65 + n;
        u32x4 o; o.x = pk2(s[0 * 65], s[1 * 65]); o.y = pk2(s[2 * 65], s[3 * 65]); o.z = pk2(s[4 * 65], s[5 * 65]); o.w = pk2(s[6 * 65], s[7 * 65]);
        *(u32x4*)(WT + (size_t)(row_off + n0 + n) * K + k0 + 8 * c) = o; }
    asm volatile("s_waitcnt lgkmcnt(0)" ::: "memory");
}

struct Params {
    const float* x_prompt; const float* x_sample; const float* cache_conv; const float* cache_k; const float* cache_v;
    const float* norm_a; const float* w_in_a; const float* conv_w; const float* w_out_a; const float* norm_kv; const float* w_kv;
    const float* norm_b; const float* w_q; const float* w_o; const float* sinks; const float* norm_ffn; const float* w_gu; const float* w_down; const float* norm_final;
    float* out; unsigned char* ws;
};

__device__ __forceinline__ void convert_set(const Params& P, LAS unsigned char* lds, int wid, int lane, int set, int w, int nw) {
    asm volatile("" : "+v"(lane));
    LAS float* scr = (LAS float*)(lds + wid * LDS_P0SCR);
    unsigned char* ws = P.ws;
    constexpr int I_IN = 16 * 48, I_SQ = 16 * 16, I_GU = 16 * 88, I_DN = 44 * 16, I_KV = 16 * 8;
    const int n_head = (set < 2) ? (I_IN + I_SQ) : ((set == 2 ? I_KV : 0) + 2 * I_SQ);
    const int nitems = n_head + I_GU + I_DN;
    for (int it = w; it < nitems; it += nw) {
        int r = it;
        if (r < n_head) {
            if (set < 2) {
                if (r < I_IN) { p0_transpose_item(P.w_in_a + (size_t)set * 1024 * 3072, P.norm_a + set * 1024, 1024, 3072, (bf16_t*)(ws + WS_WIN + set * SZ_WIN), 0, scr, r, lane); continue; } r -= I_IN;
                p0_transpose_item(P.w_out_a + (size_t)set * 1024 * 1024, nullptr, 1024, 1024, (bf16_t*)(ws + WS_WOUT + set * SZ_SQ), 0, scr, r, lane); continue;
            } else {
                const int a = set - 2;
                if (set == 2) { if (r < I_KV) { p0_transpose_item(P.w_kv, P.norm_kv, 1024, 512, (bf16_t*)(ws + WS_WKVQ), 0, scr, r, lane); continue; } r -= I_KV; }
                if (r < I_SQ) { p0_transpose_item(P.w_q + (size_t)a * 1024 * 1024, P.norm_b + a * 1024, 1024, 1024, (bf16_t*)(ws + (a == 0 ? WS_WKVQ : WS_WQ1)), a == 0 ? 512 : 0, scr, r, lane); continue; } r -= I_SQ;
                p0_transpose_item(P.w_o + (size_t)a * 1024 * 1024, nullptr, 1024, 1024, (bf16_t*)(ws + WS_WO + a * SZ_SQ), 0, scr, r, lane); continue;
            }
        }
        r -= n_head;
        if (r < I_GU) { p0_transpose_item(P.w_gu + (size_t)set * 1024 * 5632, P.norm_ffn + set * 1024, 1024, 5632, (bf16_t*)(ws + WS_WGU + set * SZ_WGU), 0, scr, r, lane); continue; } r -= I_GU;
        p0_transpose_item(P.w_down + (size_t)set * 2816 * 1024, nullptr, 2816, 1024, (bf16_t*)(ws + WS_WDN + set * SZ_WDN), 0, scr, r, lane);
    }
}

__device__ __forceinline__ void p0_prologue(const Params& P, LAS unsigned char* lds, int wid, int lane) {
    asm volatile("" : "+v"(lane));
    const int gw = blockIdx.x * 8 + wid, NGW = gridDim.x * 8;
    unsigned char* ws = P.ws;
    convert_set(P, lds, wid, lane, 0, gw, NGW);
    bf16_t* xb = (bf16_t*)(ws + WS_XB); float* ssq = (float*)(ws + WS_SSQ);
    for (int row = gw; row < MT; row += NGW) {
        const float* src = (row < MP) ? P.x_prompt + (size_t)row * D : P.x_sample + (size_t)(row - MP) * D;
        float ss = 0.f;
#pragma unroll
        for (int j = 0; j < 4; ++j) { const f32x4 v = *((const f32x4*)src + lane + 64 * j);
            ss += (v[0] * v[0] + v[1] * v[1]) + (v[2] * v[2] + v[3] * v[3]); st_bf4(xb + (size_t)row * D + 4 * (lane + 64 * j), v); }
#pragma unroll
        for (int o = 1; o < 64; o <<= 1) ss += __shfl_xor(ss, o);
        if (lane < 16) ssq[(size_t)row * 16 + lane] = (lane == 0) ? ss : 0.f;
    }
    int gt_ = threadIdx.x; asm volatile("" : "+v"(gt_)); const int gt = blockIdx.x * 512 + gt_, NGT = gridDim.x * 512;
    float* cosT = (float*)(ws + WS_COS); float* sinT = (float*)(ws + WS_SIN);
    for (int idx = gt; idx < 8193 * 32; idx += NGT) {
        const int pos = idx >> 5, i = idx & 31;
        const float freq = (float)exp2((double)(-i) * (13.287712379549449 / 32.0));
        const float ang = (float)pos * freq;
        double rev = (double)ang * 0.15915494309189535; rev = rev - rint(rev);
        const float rf = (float)rev;
        cosT[idx] = __builtin_amdgcn_cosf(rf); sinT[idx] = __builtin_amdgcn_sinf(rf);
    }
    for (int idx = gt; idx < 128 * 127 * 64; idx += NGT) {
        const int n = idx / 8128, r = idx % 8128;
        const f32x4 kv = *((const f32x4*)(P.cache_k + (size_t)n * 32768 + 256) + r), vv = *((const f32x4*)(P.cache_v + (size_t)n * 32768 + 256) + r);
        *((f32x4*)(P.out + OUT_KWS + (size_t)n * 32768) + r) = kv; *((f32x4*)(P.out + OUT_VWS + (size_t)n * 32768) + r) = vv;
    }
    for (int idx = gt; idx < 2 * 128 * 256; idx += NGT) {
        const int ln = idx >> 8, r = idx & 255;
        *((f32x4*)(P.out + OUT_CONVS + (size_t)ln * 2048) + r) = *((const f32x4*)(P.cache_conv + (size_t)ln * 2048 + 1024) + r);
    }
}

__device__ __forceinline__ int crow(int r, int hi) { return (r & 3) + 8 * (r >> 2) + 4 * hi; }
constexpr int KSTR = 144, VSTR = 520, LDS_VT = 256 * KSTR;

__device__ __forceinline__ void attn_prompt_unit(LAS unsigned char* lds, int b, int qblk, int kvh, const bf16_t* qb, const bf16_t* kb, const bf16_t* vT, bf16_t* ob, const float* sinks, int wid, int lane) {
    int tid_ = threadIdx.x; asm volatile("" : "+v"(tid_)); const int tid = tid_; lane = tid & 63;
    __syncthreads();
    const long rowbase = (long)b * SEQ + (long)(qblk - 1) * WIN;
#pragma unroll
    for (int i = 0; i < 4; ++i) { const int c = tid + i * 512, key = c >> 3, part = c & 7;
        if (qblk > 0 || key >= WIN) { const u32x4 v = *(const u32x4*)(kb + (size_t)(rowbase + key) * 256 + kvh * 64 + part * 8); *(LAS u32x4*)(lds + key * KSTR + part * 16) = v; } }
#pragma unroll
    for (int i = 0; i < 4; ++i) { const int c = tid + i * 512, d = c >> 5, part = c & 31;
        if (qblk > 0 || part >= 16) { const u32x4 v = *(const u32x4*)(vT + (size_t)((b * 4 + kvh) * 64 + d) * SEQ + (long)(qblk - 1) * WIN + part * 8);
            LAS unsigned* dst = (LAS unsigned*)(lds + LDS_VT + d * VSTR + part * 16); dst[0] = v.x; dst[1] = v.y; dst[2] = v.z; dst[3] = v.w; } }
    const int ql = lane & 31, hi = lane >> 5, head = kvh * 4 + (wid >> 1);
    bf16x8 qfa[2][4];
#pragma unroll
    for (int i = 0; i < 2; ++i)
#pragma unroll
        for (int s = 0; s < 4; ++s) qfa[i][s] = *(const bf16x8*)(qb + ((size_t)b * SEQ + (size_t)qblk * WIN + (wid & 1) * 64 + i * 32 + ql) * D + head * 64 + s * 16 + hi * 8);
    const float sink2 = sinks[head] * LOG2E;
    __syncthreads();
#pragma unroll
    for (int i = 0; i < 2; ++i) {
        const int r0 = (wid & 1) * 64 + i * 32, kb0 = r0 >> 5;
        const size_t qrow = (size_t)b * SEQ + (size_t)qblk * WIN + r0 + ql;
        bf16x8 qf[4];
#pragma unroll
        for (int s = 0; s < 4; ++s) qf[s] = qfa[i][s];
        f32x16 S[5];
#pragma unroll
        for (int jb = 0; jb < 5; ++jb) {
            const int kblk = kb0 + jb;
            f32x16 a;
#pragma unroll
            for (int r = 0; r < 16; ++r) a[r] = 0.f;
            if (qblk > 0 || kblk >= 4) {
#pragma unroll
                for (int s = 0; s < 4; ++s) { const bf16x8 kf = *(const LAS bf16x8*)(lds + (kblk * 32 + ql) * KSTR + (s * 16 + hi * 8) * 2);
                    a = __builtin_amdgcn_mfma_f32_32x32x16_bf16(kf, qf[s], a, 0, 0, 0); }
            } else {
#pragma unroll
                for (int r = 0; r < 16; ++r) a[r] = -INFINITY;
            }
            S[jb] = a;
        }
#pragma unroll
        for (int r = 0; r < 16; ++r) { const int kk = crow(r, hi); if (!(kk > ql)) S[0][r] = -INFINITY; if (!(kk <= ql)) S[4][r] = -INFINITY; }
        float mx = sink2;
#pragma unroll
        for (int jb = 0; jb < 5; ++jb)
#pragma unroll
            for (int r = 0; r < 16; ++r) mx = fmaxf(mx, S[jb][r]);
        mx = fmaxf(mx, __shfl_xor(mx, 32));
        float sum = 0.f;
#pragma unroll
        for (int jb = 0; jb < 5; ++jb)
#pragma unroll
            for (int r = 0; r < 16; ++r) { const float p = __builtin_amdgcn_exp2f(S[jb][r] - mx); S[jb][r] = p; sum += p; }
        sum += __shfl_xor(sum, 32);
        const float rinv = 1.0f / (sum + __builtin_amdgcn_exp2f(sink2 - mx));
        f32x16 o0, o1;
#pragma unroll
        for (int r = 0; r < 16; ++r) { o0[r] = 0.f; o1[r] = 0.f; }
#pragma unroll
        for (int jb = 0; jb < 5; ++jb) {
            const int kblk = kb0 + jb;
            if (qblk > 0 || kblk >= 4) {
#pragma unroll
                for (int s2 = 0; s2 < 2; ++s2) {
                    u32x4 pw; pw.x = cvt_pk_bf16(S[jb][8 * s2 + 0], S[jb][8 * s2 + 1]); pw.y = cvt_pk_bf16(S[jb][8 * s2 + 2], S[jb][8 * s2 + 3]);
                    pw.z = cvt_pk_bf16(S[jb][8 * s2 + 4], S[jb][8 * s2 + 5]); pw.w = cvt_pk_bf16(S[jb][8 * s2 + 6], S[jb][8 * s2 + 7]);
                    const bf16x8 pf = __builtin_bit_cast(bf16x8, pw);
                    const int keybase = kblk * 32 + 16 * s2 + 4 * hi;
#pragma unroll
                    for (int dblk = 0; dblk < 2; ++dblk) {
                        const LAS unsigned char* vp = lds + LDS_VT + (dblk * 32 + ql) * VSTR + keybase * 2;
                        const u32x2 lo = *(const LAS u32x2*)vp, hh = *(const LAS u32x2*)(vp + 16);
                        const u32x4 vw = (u32x4){lo.x, lo.y, hh.x, hh.y}; const bf16x8 vf = __builtin_bit_cast(bf16x8, vw);
                        if (dblk == 0) o0 = __builtin_amdgcn_mfma_f32_32x32x16_bf16(vf, pf, o0, 0, 0, 0);
                        else o1 = __builtin_amdgcn_mfma_f32_32x32x16_bf16(vf, pf, o1, 0, 0, 0);
                    }
                }
            }
        }
        bf16_t* op = ob + qrow * D + head * 64;
#pragma unroll
        for (int dblk = 0; dblk < 2; ++dblk) {
            u32x2 ch[4];
#pragma unroll
            for (int g = 0; g < 4; ++g) { const f32x16& oo = dblk == 0 ? o0 : o1; ch[g].x = cvt_pk_bf16(oo[4 * g] * rinv, oo[4 * g + 1] * rinv); ch[g].y = cvt_pk_bf16(oo[4 * g + 2] * rinv, oo[4 * g + 3] * rinv); }
#pragma unroll
            for (int gp = 0; gp < 2; ++gp) {
                const u32x2 give = hi == 0 ? ch[2 * gp + 1] : ch[2 * gp];
                u32x2 got; got.x = (unsigned)__shfl_xor((int)give.x, 32); got.y = (unsigned)__shfl_xor((int)give.y, 32);
                const int g = 2 * gp + hi; const u32x2 mine = hi == 0 ? ch[2 * gp] : ch[2 * gp + 1];
                u32x4 p; if (hi == 0) { p.x = mine.x; p.y = mine.y; p.z = got.x; p.w = got.y; } else { p.x = got.x; p.y = got.y; p.z = mine.x; p.w = mine.y; }
                *(u32x4*)(op + dblk * 32 + 8 * g) = p;
            }
        }
    }
}

__device__ __forceinline__ void attn_sample_task(int n, int head, const bf16_t* qb, const float* kws, const float* vws, bf16_t* ob, const float* sinks, int lane) {
    asm volatile("" : "+v"(lane));
    const int kvh = head >> 2; const size_t qrow = (size_t)MP + n;
    const float sink2 = sinks[head] * LOG2E;
    const bf16_t* qp = qb + qrow * D + head * 64;
    const float* k0 = kws + ((size_t)(n * WIN + lane) * 4 + kvh) * 64; const float* k1 = k0 + (size_t)64 * 256;
    const int kq = lane >> 4, dq = lane & 15;
    const float* vp = vws + ((size_t)(n * WIN + kq) * 4 + kvh) * 64 + 4 * dq;
    f32x4 vv[32];
#pragma unroll
    for (int i = 0; i < 32; ++i) vv[i] = *(const f32x4*)(vp + (size_t)i * 1024);
    float s0 = 0.f, s1 = 0.f;
#pragma unroll
    for (int c = 0; c < 8; ++c) {
        const u32x4 qw = *(const u32x4*)(qp + c * 8);
        const float q0 = bf_lo(qw.x), q1 = bf_hi(qw.x), q2 = bf_lo(qw.y), q3 = bf_hi(qw.y), q4 = bf_lo(qw.z), q5 = bf_hi(qw.z), q6 = bf_lo(qw.w), q7 = bf_hi(qw.w);
        const f32x4 a0 = *(const f32x4*)(k0 + c * 8), a1 = *(const f32x4*)(k0 + c * 8 + 4), b0 = *(const f32x4*)(k1 + c * 8), b1 = *(const f32x4*)(k1 + c * 8 + 4);
        s0 += q0 * a0[0] + q1 * a0[1] + q2 * a0[2] + q3 * a0[3] + q4 * a1[0] + q5 * a1[1] + q6 * a1[2] + q7 * a1[3];
        s1 += q0 * b0[0] + q1 * b0[1] + q2 * b0[2] + q3 * b0[3] + q4 * b1[0] + q5 * b1[1] + q6 * b1[2] + q7 * b1[3];
    }
    float mx = fmaxf(fmaxf(s0, s1), sink2);
#pragma unroll
    for (int o = 1; o < 64; o <<= 1) mx = fmaxf(mx, __shfl_xor(mx, o));
    const float p0 = __builtin_amdgcn_exp2f(s0 - mx), p1 = __builtin_amdgcn_exp2f(s1 - mx);
    float sum = p0 + p1;
#pragma unroll
    for (int o = 1; o < 64; o <<= 1) sum += __shfl_xor(sum, o);
    const float rinv = 1.0f / (sum + __builtin_amdgcn_exp2f(sink2 - mx));
    f32x4 o4 = (f32x4){0.f, 0.f, 0.f, 0.f};
#pragma unroll
    for (int i = 0; i < 32; ++i) { const int key = 4 * i + kq; const float p = __shfl((i < 16) ? p0 : p1, key & 63); o4 += vv[i] * p; }
#pragma unroll
    for (int e = 0; e < 4; ++e) { o4[e] += __shfl_xor(o4[e], 16); o4[e] += __shfl_xor(o4[e], 32); }
    if (kq == 0) st_bf4(ob + qrow * D + head * 64 + 4 * dq, o4 * rinv);
}

__device__ __forceinline__ void attn_phase(LAS unsigned char* lds, const Params& P, int layer, int wid, int lane) {
    unsigned char* ws = P.ws;
    const bf16_t* qb = (const bf16_t*)(ws + WS_ACT); bf16_t* ob = (bf16_t*)(ws + WS_ACT + SZ_ACT1K);
    const bf16_t* kb = (const bf16_t*)(ws + WS_K); const bf16_t* vT = (const bf16_t*)(ws + WS_VT);
    const float* sinks = P.sinks + layer * 16;
    for (int task = blockIdx.x * 8 + wid; task < MS * 16; task += gridDim.x * 8)
        attn_sample_task(task >> 4, task & 15, qb, P.out + OUT_KWS, P.out + OUT_VWS, ob, sinks, lane);
    for (int uidx = blockIdx.x; uidx < 512; uidx += gridDim.x) {
        const int kvh = uidx & 3, bq = uidx >> 2, b = bq >> 6, qblk = bq & 63;
        attn_prompt_unit(lds, b, qblk, kvh, qb, kb, vT, ob, sinks, wid, lane);
    }
    __syncthreads();
}

__global__ void __launch_bounds__(512, 2) yoco_fwd(Params P) {
    extern __shared__ __attribute__((aligned(16))) unsigned char lds_raw[];
    LAS unsigned char* lds = (LAS unsigned char*)lds_raw;
    cg::grid_group grid = cg::this_grid();
    const int tid = threadIdx.x, lane0 = tid & 63, wid_first = __builtin_amdgcn_readfirstlane(tid >> 6);
    const int G0 = gridDim.x, bid0 = blockIdx.x, wid0 = wid_first;
    unsigned char* ws = P.ws;
    float* x = P.out + OUT_Y;
    bf16_t* xb = (bf16_t*)(ws + WS_XB);
    float* ssq = (float*)(ws + WS_SSQ);
    bf16_t* actb = (bf16_t*)(ws + WS_ACT);
    bf16_t* ub = (bf16_t*)(ws + WS_ACT);
    bf16_t* zb = (bf16_t*)(ws + WS_ACT + SZ_ACT1K);
    LAS float* linv = (LAS float*)(lds + LDS_LINV);
    constexpr int NM = MP / 256;

    int G = G0, bid = bid0, wid = wid0;
#define MINI_ASSIGN(nunits) const int rem_ = (nunits) % G; const int nblk_ = G - rem_; const int bi_ = (bid >= rem_) ? bid - rem_ : (1 << 28)
    unsigned* barw = (unsigned*)(ws + WS_BAR);
    volatile LAS unsigned* barst = (volatile LAS unsigned*)(lds + LDS_BARST);
    if (tid < 2) barst[tid] = 0u;
    __syncthreads();
    const XcdBarrier xbar = xcd_barrier_post(barw, barst);
    if (P.out == nullptr) grid.sync();
    for (int rep = 0; rep < REP_P0; ++rep) p0_prologue(P, lds, wid, lane0);
#define GRID_BAR() xcd_barrier(xbar)
    GRID_BAR();
    for (int rep = 0; rep < EXTRA_SYNCS; ++rep) GRID_BAR();

    for (int li = 0; li < 4; ++li) {
        int G = G0, bid = bid0, wid = wid0; asm volatile("" : "+s"(G), "+s"(bid), "+s"(wid));
        if (li < 2) {
            const int l = li;
            const bf16_t* WinT = (const bf16_t*)(ws + WS_WIN + l * SZ_WIN);
            {
                pg8::Gemm g{xb, WinT + (size_t)1024 * 1024, NM, 8, 1024, 128, 1024}; pg8::StaticOrder S; S.init(NM, 8, G, bid);
                EpiU E{linv, ub, ssq, P.out + OUT_CONVP + (size_t)l * 4096, P.out + OUT_CONVS + (size_t)l * 128 * 2048, zb, P.conv_w + (size_t)l * 3 * 1024, P.cache_conv + (size_t)l * 128 * 2048};
                for (int rep = 0; rep < REP_U; ++rep) pg8::gemm_phase<EpiU>(lds, g, S, E);
                { MINI_ASSIGN(NM * 8); mini_phase<EpiU, 3>(lds, g.A, g.Bt, 1024, 1024, -1024, 32, 32, E, ssq, bi_, nblk_); }
            }
            GRID_BAR();
            {
                pg8::Gemm g{xb, WinT, NM, 4, 1024, 256, 128}; pg8::StaticOrder S; S.init(NM, 4, G, bid);
                EpiZ E{linv, zb, ub, ssq, P.conv_w + (size_t)l * 3 * 1024, P.cache_conv + (size_t)l * 128 * 2048};
                pg8::gemm_phase<EpiZ>(lds, g, S, E);
            }
            GRID_BAR();
            {
                pg8::Gemm g{zb, (const bf16_t*)(ws + WS_WOUT + l * SZ_SQ), NM, 4, 1024, 256, 128}; pg8::StaticOrder S; S.init(NM, 4, G, bid);
                EpiX E{xb, ssq};
                pg8::gemm_phase<EpiX>(lds, g, S, E);
                { MINI_ASSIGN(NM * 4); mini_phase<EpiX, 2>(lds, g.A, g.Bt, 1024, 32, 0, 64, 16, E, ssq, bi_, nblk_); }
            }
            GRID_BAR();
        } else {
            const int l = li - 2;
            if (l == 0) {
                pg8::Gemm g{xb, (const bf16_t*)(ws + WS_WKVQ), NM + 1, 6, 1024, 256, 32}; pg8::StaticOrder S; S.init(NM + 1, 6, G, bid);
                EpiKVQ E{linv, ssq, (const float*)(ws + WS_COS), (const float*)(ws + WS_SIN), (bf16_t*)(ws + WS_K), (bf16_t*)(ws + WS_VT), ub, P.out, 0, 1, 2, lds + LDS_VSCR};
                pg8::gemm_phase<EpiKVQ>(lds, g, S, E);
            } else {
                pg8::Gemm g{xb, (const bf16_t*)(ws + WS_WQ1), NM, 4, 1024, 256, 32}; pg8::StaticOrder S; S.init(NM, 4, G, bid);
                EpiKVQ E{linv, ssq, (const float*)(ws + WS_COS), (const float*)(ws + WS_SIN), (bf16_t*)(ws + WS_K), (bf16_t*)(ws + WS_VT), ub, P.out, -1, -1, 0, lds + LDS_VSCR};
                pg8::gemm_phase<EpiKVQ>(lds, g, S, E);
                { MINI_ASSIGN(NM * 4); mini_phase<EpiKVQ, 2>(lds, g.A, g.Bt, 1024, 32, 0, 64, 16, E, ssq, bi_, nblk_); }
            }
            GRID_BAR();
            for (int rep = 0; rep < REP_ATT; ++rep) attn_phase(lds, P, l, wid, lane0);
            GRID_BAR();
            {
                pg8::Gemm g{zb, (const bf16_t*)(ws + WS_WO + l * SZ_SQ), NM, 4, 1024, 256, 128}; pg8::StaticOrder S; S.init(NM, 4, G, bid);
                EpiX E{xb, ssq};
                pg8::gemm_phase<EpiX>(lds, g, S, E);
                { MINI_ASSIGN(NM * 4); mini_phase<EpiX, 2>(lds, g.A, g.Bt, 1024, 32, 0, 64, 16, E, ssq, bi_, nblk_); }
            }
            GRID_BAR();
        }
        {
            pg8::Gemm g{xb, (const bf16_t*)(ws + WS_WGU + li * SZ_WGU), NM + 1, 22, 1024, 128, 2816}; pg8::StaticOrder S; S.init(NM + 1, 22, G, bid);
            EpiAct E{linv, actb, ssq};
            for (int rep = 0; rep < REP_ACT; ++rep) pg8::gemm_phase<EpiAct>(lds, g, S, E);
            if (li < 3) { const int rem_ = ((NM + 1) * 22) % G;
                if (bid >= rem_) convert_set(P, lds, wid, lane0, li + 1, (bid - rem_) * 8 + wid, (G - rem_) * 8); }
        }
        GRID_BAR();
        {
            pg8::Gemm g{actb, (const bf16_t*)(ws + WS_WDN + li * SZ_WDN), NM, 4, 2816, 256, 128}; pg8::StaticOrder S; S.init(NM, 4, G, bid);
            EpiX E{xb, ssq};
            pg8::gemm_phase<EpiX>(lds, g, S, E);
            { MINI_ASSIGN(NM * 4); mini_phase<EpiX, 2>(lds, g.A, g.Bt, 2816, 32, 0, 64, 16, E, ssq, bi_, nblk_); }
        }
        GRID_BAR();
    }
    {
        const int gw = bid * 8 + wid, NGW = G * 8; int lane = lane0; asm volatile("" : "+v"(lane));
        for (int row = gw; row < MT; row += NGW) {
            const f32x4* p = (const f32x4*)(ssq + (size_t)row * 16);
            const f32x4 a = p[0], b = p[1], c = p[2], d = p[3];
            const float s = ((a[0] + a[1]) + (a[2] + a[3])) + ((b[0] + b[1]) + (b[2] + b[3])) + ((c[0] + c[1]) + (c[2] + c[3])) + ((d[0] + d[1]) + (d[2] + d[3]));
            const float iv = __builtin_amdgcn_rsqf(s * (1.0f / 1024.0f) + EPS);
#pragma unroll
            for (int j = 0; j < 4; ++j) { const int c = 4 * (lane + 64 * j); const f32x4 gv = *(const f32x4*)(P.norm_final + c);
                *(f32x4*)(x + (size_t)row * D + c) = ld_bf4(xb + (size_t)row * D + c) * iv * gv; }
        }
    }
}

extern "C" void kernel_launch(void* const* d_in, const int* in_sizes, int n_in, void* d_out, int out_size, void* d_ws, size_t ws_size, hipStream_t stream) {
    static int grid_blocks = 0;
    if (grid_blocks == 0) {
        if (n_in != 19 || (size_t)out_size != OUT_TOTAL || ws_size < WS_END) { fprintf(stderr, "kernel_launch: unexpected shapes (n_in %d out %d ws %zu need %zu)\n", n_in, out_size, ws_size, (size_t)WS_END); grid_blocks = -1; return; }
        int dev = 0, cus = 0, per_cu = 0;
        hipGetDevice(&dev);
        hipDeviceGetAttribute(&cus, hipDeviceAttributeMultiprocessorCount, dev);
        hipFuncSetAttribute((const void*)yoco_fwd, hipFuncAttributeMaxDynamicSharedMemorySize, LDS_BYTES);
        hipOccupancyMaxActiveBlocksPerMultiprocessor(&per_cu, (const void*)yoco_fwd, 512, LDS_BYTES);
        if (per_cu < 1) { fprintf(stderr, "kernel_launch: occupancy query says %d blocks per CU\n", per_cu); per_cu = 1; }
        (void)hipGetLastError();
        grid_blocks = cus * per_cu;
    }
    if (grid_blocks < 0) return;
    Params p{};
    p.x_prompt = (const float*)d_in[0]; p.x_sample = (const float*)d_in[1]; p.cache_conv = (const float*)d_in[2]; p.cache_k = (const float*)d_in[3]; p.cache_v = (const float*)d_in[4];
    p.norm_a = (const float*)d_in[5]; p.w_in_a = (const float*)d_in[6]; p.conv_w = (const float*)d_in[7]; p.w_out_a = (const float*)d_in[8]; p.norm_kv = (const float*)d_in[9]; p.w_kv = (const float*)d_in[10];
    p.norm_b = (const float*)d_in[11]; p.w_q = (const float*)d_in[12]; p.w_o = (const float*)d_in[13]; p.sinks = (const float*)d_in[14]; p.norm_ffn = (const float*)d_in[15]; p.w_gu = (const float*)d_in[16]; p.w_down = (const float*)d_in[17]; p.norm_final = (const float*)d_in[18];
    p.out = (float*)d_out; p.ws = (unsigned char*)d_ws;
    if (hipMemsetAsync((unsigned char*)d_ws + WS_BAR, 0, 16384, stream) != hipSuccess) { fprintf(stderr, "kernel_launch: hipMemsetAsync of the barrier words failed\n"); return; }
    void* args[] = {&p};
    hipError_t e = hipLaunchCooperativeKernel((const void*)yoco_fwd, dim3(grid_blocks), dim3(512), args, LDS_BYTES, stream);
    if (e != hipSuccess) fprintf(stderr, "cooperative launch failed: %s (grid %d)\n", hipGetErrorString(e), grid_blocks);
}
```

```cpp
#include <hip/hip_runtime.h>
#include <hip/hip_cooperative_groups.h>
#include <cstdio>
#include <cstdint>
namespace cg = cooperative_groups;

#define LAS __attribute__((address_space(3)))
typedef unsigned short bf16_t;
typedef short bf16x8 __attribute__((ext_vector_type(8)));
typedef float f32x4 __attribute__((ext_vector_type(4)));
typedef float f32x16 __attribute__((ext_vector_type(16)));
typedef unsigned u32x4 __attribute__((ext_vector_type(4)));
typedef unsigned u32x2 __attribute__((ext_vector_type(2)));

constexpr int D = 1024, SEQ = 8192, MP = 16384, MS = 128, MT = MP + MS, MR = MP + 256, FF = 2816;
constexpr int WIN = 128;
constexpr float EPS = 1e-6f;
constexpr float LOG2E = 1.4426950408889634f;
constexpr float QSCALE = 0.125f * LOG2E;

constexpr size_t OUT_Y = 0;
constexpr size_t OUT_CONVP = (size_t)MT * D;
constexpr size_t OUT_KWP = OUT_CONVP + 8192;
constexpr size_t OUT_VWP = OUT_KWP + 65536;
constexpr size_t OUT_CONVS = OUT_VWP + 65536;
constexpr size_t OUT_KWS = OUT_CONVS + 524288;
constexpr size_t OUT_VWS = OUT_KWS + 4194304;
constexpr size_t OUT_TOTAL = OUT_VWS + 4194304;

constexpr size_t WS_WIN = 0;
constexpr size_t SZ_WIN = (size_t)3072 * 1024 * 2;
constexpr size_t WS_WOUT = WS_WIN + 2 * SZ_WIN;
constexpr size_t SZ_SQ = (size_t)1024 * 1024 * 2;
constexpr size_t WS_WGU = WS_WOUT + 2 * SZ_SQ;
constexpr size_t SZ_WGU = (size_t)5632 * 1024 * 2;
constexpr size_t WS_WDN = WS_WGU + 4 * SZ_WGU;
constexpr size_t SZ_WDN = (size_t)1024 * 2816 * 2;
constexpr size_t WS_WKVQ = WS_WDN + 4 * SZ_WDN;
constexpr size_t WS_WQ1 = WS_WKVQ + (size_t)1536 * 1024 * 2;
constexpr size_t WS_WO = WS_WQ1 + SZ_SQ;
constexpr size_t WS_XB = WS_WO + 2 * SZ_SQ;
constexpr size_t SZ_ACT1K = (size_t)MR * 1024 * 2;
constexpr size_t WS_ACT = WS_XB + SZ_ACT1K;
constexpr size_t WS_K = WS_ACT + (size_t)MR * FF * 2;
constexpr size_t WS_VT = WS_K + (size_t)MR * 256 * 2;
constexpr size_t WS_SSQ = WS_VT + (size_t)512 * 8192 * 2;
constexpr size_t WS_COS = WS_SSQ + (size_t)MR * 16 * 4;
constexpr size_t WS_SIN = WS_COS + (size_t)8193 * 32 * 4 + 128;
constexpr size_t WS_BAR = WS_SIN + (size_t)8193 * 32 * 4 + 128;
constexpr size_t WS_END = WS_BAR + 16384;

constexpr int LDS_P0SCR = 64 * 65 * 4;
constexpr int LDS_LINV = 8 * LDS_P0SCR;
constexpr int LDS_BARST = LDS_LINV + 1024;
constexpr int LDS_VSCR = LDS_BARST + 64;
constexpr int LDS_BYTES = LDS_VSCR + 8 * 64 * 48;
#define REP_P0 1
#define REP_ATT 1
#define REP_ACT 1
#define REP_U 1
#define EXTRA_SYNCS 0

__device__ __forceinline__ unsigned cvt_pk_bf16(float lo, float hi) { unsigned r; asm volatile("v_cvt_pk_bf16_f32 %0, %1, %2" : "=v"(r) : "v"(lo), "v"(hi)); return r; }
__device__ __forceinline__ float bf_lo(unsigned w) { return __uint_as_float(w << 16); }
__device__ __forceinline__ float bf_hi(unsigned w) { return __uint_as_float(w & 0xffff0000u); }
__device__ __forceinline__ f32x4 ld_bf4(const bf16_t* p) { const u32x2 w = *(const u32x2*)p; return (f32x4){bf_lo(w.x), bf_hi(w.x), bf_lo(w.y), bf_hi(w.y)}; }
__device__ __forceinline__ void st_bf4(bf16_t* p, f32x4 v) { u32x2 w; w.x = cvt_pk_bf16(v[0], v[1]); w.y = cvt_pk_bf16(v[2], v[3]); *(u32x2*)p = w; }

namespace pg8 {
constexpr int BM = 256, BK = 64, HALF = 128, HTB = HALF * BK * 2, STAGE_BYTES = 8 * HTB, NXCD = 8, WGM = 8;
__device__ __forceinline__ int lds_byte(int r, int c) { const int st = (r >> 4) * 2 + (c >> 5), rr = r & 15, cc = c & 31, ob = rr * 64 + cc * 2; return st * 1024 + (ob ^ (((ob >> 9) & 1) << 5)); }
__device__ __forceinline__ void stage_rc(int b, int& R, int& C) { const int st = b / 1024, sb = b % 1024, swz = sb ^ (((sb >> 9) & 1) << 5); R = (st >> 1) * 16 + swz / 64; C = (st & 1) * 32 + (swz % 64) / 2; }

__device__ __forceinline__ int perm32(int rho) { const int n = rho >> 4, i = rho & 15; return 8 * (i >> 2) + 4 * n + (i & 3); }
struct Unit { int pm, pn; };
struct Gemm { const bf16_t* A; const bf16_t* Bt; int nM, nN, K, b_tile_rows, b_half_rows; };

struct StaticOrder {
    int nM, nN, nwg, G, c;
    __device__ void init(int nM_, int nN_, int G_, int c_) { nM = nM_; nN = nN_; nwg = nM * nN; G = G_; c = c_; }
    __device__ bool next(int i, Unit& u) const {
        const long L = (long)i * G + c; if (L >= nwg) return false;
        int wgid = (int)L; { const int q = nwg / NXCD, r = nwg % NXCD, xcd = wgid % NXCD, off = wgid / NXCD; wgid = (xcd < r ? xcd * (q + 1) : r * (q + 1) + (xcd - r) * q) + off; }
        const int nig = WGM * nN, gid = wgid / nig, fm = gid * WGM, gsz = (nM - fm) < WGM ? (nM - fm) : WGM;
        u.pm = fm + ((wgid % nig) % gsz); u.pn = (wgid % nig) / gsz; return true;
    }
};

template <class Epi>
__device__ __forceinline__ void gemm_phase(LAS unsigned char* lds, const Gemm g, const StaticOrder& S, const Epi& E) {
    int tid_ = threadIdx.x; asm volatile("" : "+v"(tid_));
    const int tid = tid_, wid = __builtin_amdgcn_readfirstlane(tid >> 6), lane = tid & 63, wr = wid >> 2, wc = wid & 3, fr = lane & 15, fq = lane >> 4;
    const int K = g.K, nt = K / BK;
    unsigned voffA[2], voffB[2];
#pragma unroll
    for (int i = 0; i < 2; ++i) { int R, C; stage_rc(tid * 16 + i * 8192, R, C); const int Rp = (R & ~31) + perm32(R & 31);
        const int Rb = (Epi::BMAP == 1) ? ((Rp >> 5) * 64 + (Rp & 31)) : Rp;
        voffA[i] = (unsigned)(R * K + C) * 2u; voffB[i] = (unsigned)(Rb * K + C) * 2u; }
    const size_t kstep = (size_t)(BK * 2);
    const size_t hstepA = (size_t)HALF * K * 2;
    const size_t tstepA = 2 * hstepA;
    const size_t hstepB = (size_t)g.b_half_rows * K * 2;
    const size_t tstepB = (size_t)g.b_tile_rows * K * 2;
    const unsigned ldsw = (unsigned)wid * 1024u;
    const int aoff = lds_byte(wr * 64 + fr, fq * 8), boff = lds_byte(wc * 32 + fr, fq * 8);
#define PG8_SA(b, h) (((b) * 2 + (h)) * HTB)
#define PG8_SB(b, h) ((4 + (b) * 2 + (h)) * HTB)
#define PG8_STAGE(bufoff, gbase, voff) do { _Pragma("unroll") for (int _i = 0; _i < 2; ++_i) \
        __builtin_amdgcn_global_load_lds((const unsigned*)((const char*)(gbase) + (voff)[_i]), (LAS unsigned*)(lds + (bufoff) + ldsw + _i * 8192), 16, 0, 0); } while (0)
#define PG8_LDA(dst, b, h) do { _Pragma("unroll") for (int m = 0; m < 4; ++m) _Pragma("unroll") for (int k = 0; k < 2; ++k) dst[m][k] = *(const LAS bf16x8*)(lds + PG8_SA(b, h) + aoff + m * 2048 + k * 1024); } while (0)
#define PG8_LDB(dst, b, h) do { _Pragma("unroll") for (int n = 0; n < 2; ++n) _Pragma("unroll") for (int k = 0; k < 2; ++k) dst[n][k] = *(const LAS bf16x8*)(lds + PG8_SB(b, h) + boff + n * 2048 + k * 1024); } while (0)
#define PG8_MMA(ai, bj, At, Bt) do { __builtin_amdgcn_s_setprio(1); _Pragma("unroll") for (int m = 0; m < 4; ++m) _Pragma("unroll") for (int n = 0; n < 2; ++n) _Pragma("unroll") for (int k = 0; k < 2; ++k) \
        acc[ai][bj][m][n] = __builtin_amdgcn_mfma_f32_16x16x32_bf16(Bt[n][k], At[m][k], acc[ai][bj][m][n], 0, 0, 0); __builtin_amdgcn_s_setprio(0); } while (0)
#define PG8_WAIT_V(n) asm volatile("s_waitcnt vmcnt(" #n ")" ::: "memory")
#define PG8_WAIT_L(n) asm volatile("s_waitcnt lgkmcnt(" #n ")" ::: "memory")
#define PG8_BAR __builtin_amdgcn_s_barrier()
#define PG8_SCHED __builtin_amdgcn_sched_barrier(0)
    Unit cur, nxt; int ui = 0;
    if (!S.next(0, cur)) return;
    f32x4 acc[2][2][4][2];
#pragma unroll
    for (int a = 0; a < 2; ++a)
#pragma unroll
        for (int b = 0; b < 2; ++b)
#pragma unroll
            for (int m = 0; m < 4; ++m)
#pragma unroll
                for (int n = 0; n < 2; ++n) acc[a][b][m][n] = (f32x4){0.f, 0.f, 0.f, 0.f};
    bf16x8 At[4][2], B0[2][2], B1[2][2];
    const char* cA = (const char*)g.A + (size_t)cur.pm * tstepA; const char* cB = (const char*)g.Bt + (size_t)cur.pn * tstepB;
    PG8_STAGE(PG8_SB(0, 0), cB, voffB); PG8_STAGE(PG8_SB(0, 1), cB + hstepB, voffB); PG8_STAGE(PG8_SA(0, 0), cA, voffA); PG8_STAGE(PG8_SA(0, 1), cA + hstepA, voffA);
    if (wr == 1) PG8_BAR;
    PG8_WAIT_V(2); PG8_BAR;
    PG8_STAGE(PG8_SB(1, 0), cB + kstep, voffB); PG8_STAGE(PG8_SA(1, 0), cA + kstep, voffA); PG8_STAGE(PG8_SB(1, 1), cB + hstepB + kstep, voffB);
    PG8_WAIT_V(6); PG8_BAR;
    for (;;) {
        const bool has_next = S.next(ui + 1, nxt);
        const char* nA = has_next ? (const char*)g.A + (size_t)nxt.pm * tstepA : cA; const char* nB = has_next ? (const char*)g.Bt + (size_t)nxt.pn * tstepB : cB;
        for (int t = 0; t < nt; t += 2) {
            const bool last = (t == nt - 2);
            const char* a1 = cA + (size_t)(t + 1) * kstep;
            const char* a2 = last ? nA : cA + (size_t)(t + 2) * kstep; const char* b2 = last ? nB : cB + (size_t)(t + 2) * kstep;
            const char* a3 = a2 + kstep; const char* b3 = b2 + kstep;
            const bool tail = last && !has_next;
            PG8_LDB(B0, 0, 0); PG8_LDB(B1, 0, 1); PG8_SCHED; PG8_LDA(At, 0, 0); PG8_STAGE(PG8_SA(1, 1), a1 + hstepA, voffA);
            PG8_WAIT_V(8); PG8_WAIT_L(0); PG8_BAR; PG8_MMA(0, 0, At, B0); PG8_MMA(0, 1, At, B1); PG8_BAR; PG8_SCHED;
            PG8_LDA(At, 0, 1);
            if (!tail) { PG8_STAGE(PG8_SB(0, 0), b2, voffB); PG8_STAGE(PG8_SB(0, 1), b2 + hstepB, voffB); PG8_STAGE(PG8_SA(0, 0), a2, voffA); PG8_WAIT_V(8); } else { PG8_WAIT_V(2); }
            PG8_WAIT_L(0); PG8_BAR; PG8_MMA(1, 0, At, B0); PG8_MMA(1, 1, At, B1); PG8_BAR; PG8_SCHED;
            PG8_LDB(B0, 1, 0); PG8_LDB(B1, 1, 1); PG8_SCHED; PG8_LDA(At, 1, 0);
            if (!tail) { PG8_STAGE(PG8_SA(0, 1), a2 + hstepA, voffA); PG8_WAIT_V(8); } else { PG8_WAIT_V(0); }
            PG8_WAIT_L(0); PG8_BAR; PG8_MMA(0, 0, At, B0); PG8_MMA(0, 1, At, B1); PG8_BAR; PG8_SCHED;
            PG8_LDA(At, 1, 1);
            if (!tail) { PG8_STAGE(PG8_SB(1, 0), b3, voffB); PG8_STAGE(PG8_SB(1, 1), b3 + hstepB, voffB); PG8_STAGE(PG8_SA(1, 0), a3, voffA); PG8_WAIT_V(8); }
            PG8_WAIT_L(0); PG8_BAR; PG8_MMA(1, 0, At, B0); PG8_MMA(1, 1, At, B1); PG8_BAR; PG8_SCHED;
        }
        if (wr == 0) PG8_BAR;
        E(acc, cur, wr, wc, fr, fq);
        if (!has_next) break;
#pragma unroll
        for (int a = 0; a < 2; ++a)
#pragma unroll
            for (int b = 0; b < 2; ++b)
#pragma unroll
                for (int m = 0; m < 4; ++m)
#pragma unroll
                    for (int n = 0; n < 2; ++n) acc[a][b][m][n] = (f32x4){0.f, 0.f, 0.f, 0.f};
        cur = nxt; cA = nA; cB = nB; ++ui;
        if (wr == 1) PG8_BAR;
    }
    PG8_WAIT_V(0);
    PG8_BAR;
#undef PG8_SA
#undef PG8_SB
#undef PG8_STAGE
#undef PG8_LDA
#undef PG8_LDB
#undef PG8_MMA
#undef PG8_WAIT_V
#undef PG8_WAIT_L
#undef PG8_BAR
#undef PG8_SCHED
}
}

typedef f32x4 AccT[2][2][4][2];

__device__ __forceinline__ void load_inv(LAS float* linv, const float* ssq, int pm, int wr, int fr, float (&inv)[2][4]) {
    int tid = threadIdx.x; asm volatile("" : "+v"(tid));
    if (tid < 256) {
        const f32x4* p = (const f32x4*)(ssq + (size_t)(pm * 256 + tid) * 16);
        const f32x4 a = p[0], b = p[1], c = p[2], d = p[3];
        const float s = ((a[0] + a[1]) + (a[2] + a[3])) + ((b[0] + b[1]) + (b[2] + b[3])) + ((c[0] + c[1]) + (c[2] + c[3])) + ((d[0] + d[1]) + (d[2] + d[3]));
        linv[tid] = __builtin_amdgcn_rsqf(s * (1.0f / 1024.0f) + EPS);
    }
    asm volatile("s_waitcnt vmcnt(0) lgkmcnt(0)" ::: "memory"); __builtin_amdgcn_s_barrier(); asm volatile("" ::: "memory");
#pragma unroll
    for (int ai = 0; ai < 2; ++ai)
#pragma unroll
        for (int m = 0; m < 4; ++m) inv[ai][m] = linv[ai * 128 + wr * 64 + m * 16 + fr];
    asm volatile("s_waitcnt lgkmcnt(0)" ::: "memory");
}

struct EpiX {
    static constexpr int BMAP = 0; static constexpr bool PAIRED = false, NEEDS_INV = false, HAS_SSQ = true;
    bf16_t* xb; float* ssq;
    __device__ __forceinline__ float elem(int row, int col0, f32x4 a) const {
        bf16_t* p = xb + (size_t)row * D + col0; const f32x4 o = ld_bf4(p) + a; st_bf4(p, o);
        return (o[0] * o[0] + o[1] * o[1]) + (o[2] * o[2] + o[3] * o[3]);
    }
    __device__ __forceinline__ void operator()(const AccT& acc, const pg8::Unit& u, int wr, int wc, int fr, int fq) const {
        const int row0 = u.pm * 256 + wr * 64 + fr, col0 = u.pn * 256 + wc * 32 + 8 * fq;
        u32x4 xi[2][4][2];
#pragma unroll
        for (int ai = 0; ai < 2; ++ai)
#pragma unroll
            for (int m = 0; m < 4; ++m)
#pragma unroll
                for (int bj = 0; bj < 2; ++bj) xi[ai][m][bj] = *(const u32x4*)(xb + (size_t)(row0 + ai * 128 + m * 16) * D + col0 + bj * 128);
#pragma unroll
        for (int ai = 0; ai < 2; ++ai)
#pragma unroll
            for (int m = 0; m < 4; ++m) {
                const int row = row0 + ai * 128 + m * 16; float ss = 0.f;
#pragma unroll
                for (int bj = 0; bj < 2; ++bj) { const u32x4 w = xi[ai][m][bj];
                    const f32x4 o0 = (f32x4){bf_lo(w.x), bf_hi(w.x), bf_lo(w.y), bf_hi(w.y)} + acc[ai][bj][m][0];
                    const f32x4 o1 = (f32x4){bf_lo(w.z), bf_hi(w.z), bf_lo(w.w), bf_hi(w.w)} + acc[ai][bj][m][1];
                    u32x4 p; p.x = cvt_pk_bf16(o0[0], o0[1]); p.y = cvt_pk_bf16(o0[2], o0[3]); p.z = cvt_pk_bf16(o1[0], o1[1]); p.w = cvt_pk_bf16(o1[2], o1[3]);
                    *(u32x4*)(xb + (size_t)row * D + col0 + bj * 128) = p;
                    ss += ((o0[0] * o0[0] + o0[1] * o0[1]) + (o0[2] * o0[2] + o0[3] * o0[3])) + ((o1[0] * o1[0] + o1[1] * o1[1]) + (o1[2] * o1[2] + o1[3] * o1[3])); }
                ss += __shfl_xor(ss, 16); ss += __shfl_xor(ss, 32);
                if (fq == 0) ssq[(size_t)row * 16 + u.pn * 4 + wc] = ss;
            }
    }
    __device__ __forceinline__ float mini(int row, int cb, int c4, f32x4 v0, f32x4 v1, float) const { return elem(row, cb * 64 + c4, v0) + elem(row, cb * 64 + 32 + c4, v1); }
};

struct EpiU {
    static constexpr int BMAP = 0; static constexpr bool PAIRED = true, NEEDS_INV = true, HAS_SSQ = false;
    LAS float* linv; bf16_t* ub; const float* ssq; float* convp; float* convs; bf16_t* zb; const float* cw; const float* cache;
    __device__ __forceinline__ void elem(int row, int j0, f32x4 c, f32x4 xv, float i2) const {
        const f32x4 v = c * xv * i2;
        st_bf4(ub + (size_t)row * D + j0, v);
        if (row < MP) { const int t = row & (SEQ - 1); if (t >= SEQ - 2) *(f32x4*)(convp + ((size_t)((row >> 13) * 2 + (t - (SEQ - 2))) * D + j0)) = v; }
        else { *(f32x4*)(convs + ((size_t)((row - MP) * 2 + 1) * D + j0)) = v; }
    }
    __device__ __forceinline__ void operator()(const AccT& acc, const pg8::Unit& u, int wr, int wc, int fr, int fq) const {
        const int row0 = u.pm * 256 + wr * 64 + fr, j00 = u.pn * 128 + wc * 32 + 8 * fq;
        float inv[2][4]; load_inv(linv, ssq, u.pm, wr, fr, inv);
#pragma unroll
        for (int ai = 0; ai < 2; ++ai)
#pragma unroll
            for (int m = 0; m < 4; ++m) {
                const int row = row0 + ai * 128 + m * 16; const float i2 = inv[ai][m] * inv[ai][m];
                { const f32x4 v0 = acc[ai][0][m][0] * acc[ai][1][m][0] * i2, v1 = acc[ai][0][m][1] * acc[ai][1][m][1] * i2;
                  u32x4 p; p.x = cvt_pk_bf16(v0[0], v0[1]); p.y = cvt_pk_bf16(v0[2], v0[3]); p.z = cvt_pk_bf16(v1[0], v1[1]); p.w = cvt_pk_bf16(v1[2], v1[3]);
                  *(u32x4*)(ub + (size_t)row * D + j00) = p;
                  const int t = row & (SEQ - 1);
                  if (t >= SEQ - 2) { float* cp = convp + ((size_t)((row >> 13) * 2 + (t - (SEQ - 2))) * D + j00); *(f32x4*)cp = v0; *(f32x4*)(cp + 4) = v1; } }
                asm volatile("" ::: "memory");
            }
    }
    __device__ __forceinline__ float mini(int row, int cb, int c4, f32x4 v0, f32x4 v1, float iv) const { elem(row, cb * 32 + c4, v0, v1, iv * iv); return 0.f; }
    __device__ __forceinline__ float mini3(int row, int cb, int c4, f32x4 vc, f32x4 vxv, f32x4 vb, float iv) const {
        const int j0 = cb * 32 + c4, nn = row - MP;
        const f32x4 uu = vc * vxv * (iv * iv);
        *(f32x4*)(convs + ((size_t)(nn * 2 + 1) * D + j0)) = uu;
        const f32x4 w0 = *(const f32x4*)(cw + j0), w1 = *(const f32x4*)(cw + D + j0), w2 = *(const f32x4*)(cw + 2 * D + j0);
        const f32x4 u1 = *(const f32x4*)(cache + (size_t)(nn * 2 + 1) * D + j0), u2 = *(const f32x4*)(cache + (size_t)(nn * 2) * D + j0);
        st_bf4(zb + (size_t)row * D + j0, (vb * iv) * (w0 * u2 + w1 * u1 + w2 * uu));
        return 0.f;
    }
};

struct EpiZ {
    static constexpr int BMAP = 0; static constexpr bool PAIRED = false, NEEDS_INV = true, HAS_SSQ = false;
    LAS float* linv; bf16_t* zb; const bf16_t* ub; const float* ssq; const float* cw; const float* cache;
    __device__ __forceinline__ void operator()(const AccT& acc, const pg8::Unit& u, int wr, int wc, int fr, int fq) const {
        const int row0 = u.pm * 256 + wr * 64 + fr, col00 = u.pn * 256 + wc * 32 + 8 * fq;
        float inv[2][4]; load_inv(linv, ssq, u.pm, wr, fr, inv);
        const int lane = fq * 16 + fr, l1 = lane - 1, l2 = lane - 2, l15 = fq * 16 + 15, l14 = fq * 16 + 14;
#pragma unroll
        for (int bj = 0; bj < 2; ++bj) { u32x2 zlo[2][4];
#pragma unroll
            for (int n = 0; n < 2; ++n) { const int col0 = col00 + bj * 128 + n * 4;
                u32x2 u0[2][4], hA[2], hB[2];
#pragma unroll
                for (int ai = 0; ai < 2; ++ai) {
                    const int rb = u.pm * 256 + ai * 128 + wr * 64;
                    const int ra = (rb & (SEQ - 1)) >= 1 ? rb - 1 : rb, rbb = (rb & (SEQ - 1)) >= 2 ? rb - 2 : rb;
                    hA[ai] = *(const u32x2*)(ub + (size_t)ra * D + col0); hB[ai] = *(const u32x2*)(ub + (size_t)rbb * D + col0);
#pragma unroll
                    for (int m = 0; m < 4; ++m) u0[ai][m] = *(const u32x2*)(ub + (size_t)(row0 + ai * 128 + m * 16) * D + col0); }
                const f32x4 w0 = *(const f32x4*)(cw + col0), w1 = *(const f32x4*)(cw + D + col0), w2 = *(const f32x4*)(cw + 2 * D + col0);
#pragma unroll
                for (int ai = 0; ai < 2; ++ai)
#pragma unroll
                    for (int m = 0; m < 4; ++m) { const int row = row0 + ai * 128 + m * 16; const int t = row & (SEQ - 1);
                        const u32x2 c0 = u0[ai][m];
                        u32x2 a1, a2, p15, p14;
                        a1.x = (unsigned)__builtin_amdgcn_update_dpp(0, (int)c0.x, 0x111, 0xf, 0xf, true); a1.y = (unsigned)__builtin_amdgcn_update_dpp(0, (int)c0.y, 0x111, 0xf, 0xf, true);
                        a2.x = (unsigned)__builtin_amdgcn_update_dpp(0, (int)c0.x, 0x112, 0xf, 0xf, true); a2.y = (unsigned)__builtin_amdgcn_update_dpp(0, (int)c0.y, 0x112, 0xf, 0xf, true);
                        if (m == 0) { p15 = hA[ai]; p14 = hB[ai]; }
                        else { const u32x2 pv = u0[ai][m - 1];
                            p15.x = (unsigned)__shfl((int)pv.x, l15); p15.y = (unsigned)__shfl((int)pv.y, l15);
                            p14.x = (unsigned)__shfl((int)pv.x, l14); p14.y = (unsigned)__shfl((int)pv.y, l14); }
                        const u32x2 b1 = (fr >= 1) ? a1 : p15;
                        const u32x2 b2 = (fr >= 2) ? a2 : ((fr == 1) ? p15 : p14);
                        const f32x4 x0 = (f32x4){bf_lo(c0.x), bf_hi(c0.x), bf_lo(c0.y), bf_hi(c0.y)};
                        f32x4 x1 = (f32x4){bf_lo(b1.x), bf_hi(b1.x), bf_lo(b1.y), bf_hi(b1.y)}, x2 = (f32x4){bf_lo(b2.x), bf_hi(b2.x), bf_lo(b2.y), bf_hi(b2.y)};
                        if (t < 1) x1 = (f32x4){0.f, 0.f, 0.f, 0.f};
                        if (t < 2) x2 = (f32x4){0.f, 0.f, 0.f, 0.f};
                        const f32x4 y = w0 * x2 + w1 * x1 + w2 * x0;
                        const f32x4 zz = (acc[ai][bj][m][n] * inv[ai][m]) * y; u32x2 zw; zw.x = cvt_pk_bf16(zz[0], zz[1]); zw.y = cvt_pk_bf16(zz[2], zz[3]);
                        if (n == 0) zlo[ai][m] = zw;
                        else { u32x4 p; p.x = zlo[ai][m].x; p.y = zlo[ai][m].y; p.z = zw.x; p.w = zw.y; *(u32x4*)(zb + (size_t)row * D + col0 - 4) = p; } }
                asm volatile("" ::: "memory");
            } }
    }
};

struct EpiAct {
    static constexpr int BMAP = 0; static constexpr bool PAIRED = true, NEEDS_INV = true, HAS_SSQ = false;
    LAS float* linv; bf16_t* act; const float* ssq;
    __device__ __forceinline__ void elem(int row, int j0, f32x4 ga, f32x4 ua, float iv) const {
        const f32x4 gg = ga * iv, uu = ua * iv; f32x4 o;
#pragma unroll
        for (int e = 0; e < 4; ++e) { const float sg = __builtin_amdgcn_rcpf(1.0f + __builtin_amdgcn_exp2f(-gg[e] * LOG2E)); o[e] = gg[e] * sg * uu[e]; }
        st_bf4(act + (size_t)row * FF + j0, o);
    }
    __device__ __forceinline__ void operator()(const AccT& acc, const pg8::Unit& u, int wr, int wc, int fr, int fq) const {
        const int row0 = u.pm * 256 + wr * 64 + fr, j00 = u.pn * 128 + wc * 32 + 8 * fq;
        float inv[2][4]; load_inv(linv, ssq, u.pm, wr, fr, inv);
#pragma unroll
        for (int ai = 0; ai < 2; ++ai)
#pragma unroll
            for (int m = 0; m < 4; ++m) {
                const int row = row0 + ai * 128 + m * 16;
                { const float iv = inv[ai][m]; f32x4 o[2];
#pragma unroll
                  for (int n = 0; n < 2; ++n) { const f32x4 gg = acc[ai][0][m][n] * iv, uu = acc[ai][1][m][n] * iv;
#pragma unroll
                      for (int e = 0; e < 4; ++e) { const float sg = __builtin_amdgcn_rcpf(1.0f + __builtin_amdgcn_exp2f(-gg[e] * LOG2E)); o[n][e] = gg[e] * sg * uu[e]; } }
                  u32x4 p; p.x = cvt_pk_bf16(o[0][0], o[0][1]); p.y = cvt_pk_bf16(o[0][2], o[0][3]); p.z = cvt_pk_bf16(o[1][0], o[1][1]); p.w = cvt_pk_bf16(o[1][2], o[1][3]);
                  *(u32x4*)(act + (size_t)row * FF + j00) = p; }
                asm volatile("" ::: "memory");
            }
    }
    __device__ __forceinline__ float mini(int row, int cb, int c4, f32x4 v0, f32x4 v1, float iv) const { elem(row, cb * 32 + c4, v0, v1, iv); return 0.f; }
};

struct EpiKVQ {
    static constexpr int BMAP = 1; static constexpr bool PAIRED = false, NEEDS_INV = true, HAS_SSQ = false;
    LAS float* linv; const float* ssq; const float* cosT; const float* sinT; bf16_t* kb; bf16_t* vT; bf16_t* qb; float* out; int pn_k, pn_v, pn_q0; LAS unsigned char* vscr;
    __device__ __forceinline__ void elemV(int row, int hh, int d0, f32x4 a, float iv) const {
        const f32x4 v = a * iv;
        if (row < MP) { const int b = row >> 13, t = row & (SEQ - 1);
            bf16_t* vp = vT + ((size_t)((b * 4 + hh) * 64 + d0)) * SEQ + t;
            const unsigned w01 = cvt_pk_bf16(v[0], v[1]), w23 = cvt_pk_bf16(v[2], v[3]);
            vp[0] = (bf16_t)(w01 & 0xffffu); vp[SEQ] = (bf16_t)(w01 >> 16); vp[2 * SEQ] = (bf16_t)(w23 & 0xffffu); vp[3 * SEQ] = (bf16_t)(w23 >> 16);
            if (t >= SEQ - WIN) *(f32x4*)(out + OUT_VWP + ((size_t)((b * WIN + t - (SEQ - WIN)) * 4 + hh) * 64 + d0)) = v; }
        else if (row < MT) { *(f32x4*)(out + OUT_VWS + ((size_t)(((row - MP) * WIN + (WIN - 1)) * 4 + hh) * 64 + d0)) = v; }
    }
    __device__ __forceinline__ void elemR(int row, int head, int dlo, f32x4 a1, f32x4 a2, float iv, bool isk) const {
        const int pos = (row < MP) ? (row & (SEQ - 1)) : SEQ;
        const f32x4 c = *(const f32x4*)(cosT + (size_t)pos * 32 + dlo), s = *(const f32x4*)(sinT + (size_t)pos * 32 + dlo);
        const f32x4 x1 = a1 * iv, x2 = a2 * iv;
        const f32x4 r1 = x1 * c - x2 * s, r2 = x2 * c + x1 * s;
        if (isk) {
            st_bf4(kb + (size_t)row * 256 + head * 64 + dlo, r1); st_bf4(kb + (size_t)row * 256 + head * 64 + 32 + dlo, r2);
            if (row < MP) { const int b = row >> 13, t = row & (SEQ - 1);
                if (t >= SEQ - WIN) { float* o = out + OUT_KWP + ((size_t)((b * WIN + t - (SEQ - WIN)) * 4 + head) * 64 + dlo); *(f32x4*)o = r1; *(f32x4*)(o + 32) = r2; } }
            else if (row < MT) { float* o = out + OUT_KWS + ((size_t)(((row - MP) * WIN + (WIN - 1)) * 4 + head) * 64 + dlo); *(f32x4*)o = r1; *(f32x4*)(o + 32) = r2; }
        } else {
            st_bf4(qb + (size_t)row * D + head * 64 + dlo, r1 * QSCALE); st_bf4(qb + (size_t)row * D + head * 64 + 32 + dlo, r2 * QSCALE);
        }
    }
    __device__ __forceinline__ void operator()(const AccT& acc, const pg8::Unit& u, int wr, int wc, int fr, int fq) const {
        const int row0 = u.pm * 256 + wr * 64 + fr;
        float inv[2][4]; load_inv(linv, ssq, u.pm, wr, fr, inv);
        if (u.pn == pn_v) {
            if (u.pm * 256 < MP) {
                LAS unsigned char* scr = vscr + (wr * 4 + wc) * (64 * 48);
                const int lane = fq * 16 + fr;
#pragma unroll
                for (int ai = 0; ai < 2; ++ai)
#pragma unroll
                    for (int m = 0; m < 4; ++m) {
                        const int row = row0 + ai * 128 + m * 16; const float iv = inv[ai][m]; const int b = row >> 13, t = row & (SEQ - 1);
#pragma unroll
                        for (int bj = 0; bj < 2; ++bj)
#pragma unroll
                            for (int n = 0; n < 2; ++n) { const int d0 = 32 * bj + 8 * fq + 4 * n; const f32x4 v = acc[ai][bj][m][n] * iv;
                                const unsigned w01 = cvt_pk_bf16(v[0], v[1]), w23 = cvt_pk_bf16(v[2], v[3]);
                                LAS unsigned short* sp = (LAS unsigned short*)(scr + d0 * 48 + fr * 2);
                                sp[0] = (unsigned short)(w01 & 0xffffu); sp[24] = (unsigned short)(w01 >> 16); sp[48] = (unsigned short)(w23 & 0xffffu); sp[72] = (unsigned short)(w23 >> 16);
                                if (t >= SEQ - WIN) *(f32x4*)(out + OUT_VWP + ((size_t)((b * WIN + t - (SEQ - WIN)) * 4 + wc) * 64 + d0)) = v; }
                        asm volatile("s_waitcnt lgkmcnt(0)" ::: "memory");
                        const u32x4 q0 = *(const LAS u32x4*)(scr + lane * 48), q1 = *(const LAS u32x4*)(scr + lane * 48 + 16);
                        asm volatile("s_waitcnt lgkmcnt(0)" ::: "memory");
                        const int t0 = (u.pm * 256 + ai * 128 + wr * 64 + m * 16) & (SEQ - 1);
                        bf16_t* vp = vT + ((size_t)((b * 4 + wc) * 64 + lane)) * SEQ + t0;
                        *(u32x4*)vp = q0; *(u32x4*)(vp + 8) = q1;
                    }
            } else {
#pragma unroll
                for (int ai = 0; ai < 2; ++ai)
#pragma unroll
                    for (int m = 0; m < 4; ++m) {
                        const int row = row0 + ai * 128 + m * 16;
#pragma unroll
                        for (int bj = 0; bj < 2; ++bj)
#pragma unroll
                            for (int n = 0; n < 2; ++n) elemV(row, wc, 32 * bj + 4 * n + 8 * fq, acc[ai][bj][m][n], inv[ai][m]);
                        asm volatile("" ::: "memory");
                    }
            }
        } else {
            const bool isk = (u.pn == pn_k); const int head = isk ? wc : (u.pn - pn_q0) * 4 + wc;
#pragma unroll
            for (int ai = 0; ai < 2; ++ai)
#pragma unroll
                for (int m = 0; m < 4; ++m) {
                    const int row = row0 + ai * 128 + m * 16; int fql = fq; asm volatile("" : "+v"(fql));
                    const int dlo = 8 * fql, pos = (row < MP) ? (row & (SEQ - 1)) : SEQ; const float iv = inv[ai][m];
                    f32x4 r1[2], r2[2];
#pragma unroll
                    for (int n = 0; n < 2; ++n) { const f32x4 c = *(const f32x4*)(cosT + (size_t)pos * 32 + dlo + 4 * n), sn = *(const f32x4*)(sinT + (size_t)pos * 32 + dlo + 4 * n);
                        const f32x4 x1 = acc[ai][0][m][n] * iv, x2 = acc[ai][1][m][n] * iv; r1[n] = x1 * c - x2 * sn; r2[n] = x2 * c + x1 * sn; }
                    if (isk) {
                        u32x4 p1, p2; p1.x = cvt_pk_bf16(r1[0][0], r1[0][1]); p1.y = cvt_pk_bf16(r1[0][2], r1[0][3]); p1.z = cvt_pk_bf16(r1[1][0], r1[1][1]); p1.w = cvt_pk_bf16(r1[1][2], r1[1][3]);
                        p2.x = cvt_pk_bf16(r2[0][0], r2[0][1]); p2.y = cvt_pk_bf16(r2[0][2], r2[0][3]); p2.z = cvt_pk_bf16(r2[1][0], r2[1][1]); p2.w = cvt_pk_bf16(r2[1][2], r2[1][3]);
                        *(u32x4*)(kb + (size_t)row * 256 + head * 64 + dlo) = p1; *(u32x4*)(kb + (size_t)row * 256 + head * 64 + 32 + dlo) = p2;
                        float* o = nullptr;
                        if (row < MP) { const int b = row >> 13, t = row & (SEQ - 1); if (t >= SEQ - WIN) o = out + OUT_KWP + ((size_t)((b * WIN + t - (SEQ - WIN)) * 4 + head) * 64 + dlo); }
                        else if (row < MT) o = out + OUT_KWS + ((size_t)(((row - MP) * WIN + (WIN - 1)) * 4 + head) * 64 + dlo);
                        if (o) { *(f32x4*)o = r1[0]; *(f32x4*)(o + 4) = r1[1]; *(f32x4*)(o + 32) = r2[0]; *(f32x4*)(o + 36) = r2[1]; }
                    } else {
                        u32x4 p1, p2; p1.x = cvt_pk_bf16(r1[0][0] * QSCALE, r1[0][1] * QSCALE); p1.y = cvt_pk_bf16(r1[0][2] * QSCALE, r1[0][3] * QSCALE); p1.z = cvt_pk_bf16(r1[1][0] * QSCALE, r1[1][1] * QSCALE); p1.w = cvt_pk_bf16(r1[1][2] * QSCALE, r1[1][3] * QSCALE);
                        p2.x = cvt_pk_bf16(r2[0][0] * QSCALE, r2[0][1] * QSCALE); p2.y = cvt_pk_bf16(r2[0][2] * QSCALE, r2[0][3] * QSCALE); p2.z = cvt_pk_bf16(r2[1][0] * QSCALE, r2[1][1] * QSCALE); p2.w = cvt_pk_bf16(r2[1][2] * QSCALE, r2[1][3] * QSCALE);
                        *(u32x4*)(qb + (size_t)row * D + head * 64 + dlo) = p1; *(u32x4*)(qb + (size_t)row * D + head * 64 + 32 + dlo) = p2;
                    }
                    asm volatile("" ::: "memory");
                }
        }
    }
    __device__ __forceinline__ float mini(int row, int cb, int c4, f32x4 v0, f32x4 v1, float iv) const {
        if (pn_k >= 0 && cb >= 4 && cb < 8) { elemV(row, cb - 4, c4, v0, iv); elemV(row, cb - 4, 32 + c4, v1, iv); }
        else { const bool isk = (pn_k >= 0 && cb < 4); const int head = isk ? cb : (pn_k >= 0 ? cb - 8 : cb); elemR(row, head, c4, v0, v1, iv, isk); }
        return 0.f;
    }
};

template <class Epi, int NP>
__device__ __forceinline__ void mini_phase(LAS unsigned char* lds, const bf16_t* A, const bf16_t* Bt, int K, int pb1, int pb2, int mstr, int ncb, const Epi& E, const float* ssq_in, int bi, int nblk) {
    int tid_ = threadIdx.x; asm volatile("" : "+v"(tid_));
    const int wid = __builtin_amdgcn_readfirstlane(tid_ >> 6), lane = tid_ & 63, ql = lane & 31, hi = lane >> 5;
    const int kw = K >> 3, nst = kw >> 4;
    LAS float* part = (LAS float*)lds;
    for (int task = bi; task < 4 * ncb; task += nblk) {
        const int rb = task & 3, cb = task >> 2;
        const int row = MP + rb * 32 + 8 * (wid & 3) + (lane >> 3), c4 = 4 * (lane & 7);
        float sq = 0.f;
        if (Epi::NEEDS_INV && wid < 4) {
            const f32x4* p = (const f32x4*)(ssq_in + (size_t)row * 16);
            const f32x4 a = p[0], b = p[1], c = p[2], d = p[3];
            sq = ((a[0] + a[1]) + (a[2] + a[3])) + ((b[0] + b[1]) + (b[2] + b[3])) + ((c[0] + c[1]) + (c[2] + c[3])) + ((d[0] + d[1]) + (d[2] + d[3]));
        }
        const bf16_t* ap = A + (size_t)(MP + rb * 32 + ql) * K + wid * kw + hi * 8;
        const bf16_t* b0p = Bt + (size_t)(cb * mstr + ql) * K + wid * kw + hi * 8;
        const bf16_t* b1p = b0p + (long)pb1 * K;
        const bf16_t* b2p = b0p + (long)pb2 * K;
        f32x16 a0, a1, a2;
#pragma unroll
        for (int r = 0; r < 16; ++r) { a0[r] = 0.f; a1[r] = 0.f; a2[r] = 0.f; }
#pragma unroll 8
        for (int s = 0; s < nst; ++s) {
            const bf16x8 av = *(const bf16x8*)(ap + s * 16), w0 = *(const bf16x8*)(b0p + s * 16), w1 = *(const bf16x8*)(b1p + s * 16);
            a0 = __builtin_amdgcn_mfma_f32_32x32x16_bf16(w0, av, a0, 0, 0, 0);
            a1 = __builtin_amdgcn_mfma_f32_32x32x16_bf16(w1, av, a1, 0, 0, 0);
            if (NP == 3) { const bf16x8 w2 = *(const bf16x8*)(b2p + s * 16); a2 = __builtin_amdgcn_mfma_f32_32x32x16_bf16(w2, av, a2, 0, 0, 0); }
        }
#pragma unroll
        for (int r = 0; r < 16; ++r) { part[((wid * NP + 0) * 16 + r) * 64 + lane] = a0[r]; part[((wid * NP + 1) * 16 + r) * 64 + lane] = a1[r];
            if (NP == 3) part[((wid * NP + 2) * 16 + r) * 64 + lane] = a2[r]; }
        __syncthreads();
        if (wid < 4) {
            const int rsel = 4 * (c4 >> 3), lsel = 8 * wid + (lane >> 3) + 32 * ((c4 >> 2) & 1);
            f32x4 v[3];
#pragma unroll
            for (int p = 0; p < NP; ++p) { v[p] = (f32x4){0.f, 0.f, 0.f, 0.f};
#pragma unroll
                for (int w = 0; w < 8; ++w)
#pragma unroll
                    for (int e = 0; e < 4; ++e) v[p][e] += part[((w * NP + p) * 16 + rsel + e) * 64 + lsel]; }
            const float iv = Epi::NEEDS_INV ? __builtin_amdgcn_rsqf(sq * (1.0f / 1024.0f) + EPS) : 1.f;
            float ss;
            if constexpr (NP == 3) ss = E.mini3(row, cb, c4, v[0], v[1], v[2], iv); else ss = E.mini(row, cb, c4, v[0], v[1], iv);
            if (Epi::HAS_SSQ) { ss += __shfl_xor(ss, 1); ss += __shfl_xor(ss, 2); ss += __shfl_xor(ss, 4);
                if ((lane & 7) == 0) ((float*)ssq_in)[(size_t)row * 16 + cb] = ss; }
        }
        __syncthreads();
    }
}

#define XB_TMO      128
#define XB_XCNT(j)  (256  + 64 * (j))
#define XB_XSUB(j)  (1280 + 64 * (j))
#define XB_XGEN(j)  (2304 + 64 * (j))
#define XB_TOP      3328
#define XB_TOPGEN   3392
#define XCD_BAR_WORDS 3456
#define XB_SPIN_CAP (1u << 18)
__device__ __forceinline__ unsigned xb_ld(unsigned* p)              { return __hip_atomic_load(p, __ATOMIC_RELAXED, __HIP_MEMORY_SCOPE_AGENT); }
__device__ __forceinline__ unsigned xb_add(unsigned* p, unsigned v) { return __hip_atomic_fetch_add(p, v, __ATOMIC_RELAXED, __HIP_MEMORY_SCOPE_AGENT); }
__device__ __forceinline__ unsigned xb_xcc_id() { return (unsigned)__builtin_amdgcn_s_getreg((3 << 11) | 20) & 0xFu; }
#define XB_SPIN(cond, bar) do { unsigned _sp = 0; while (cond) { __builtin_amdgcn_s_sleep(1); \
    if ((++_sp & 255u) == 0u) { if (xb_ld(&(bar)[XB_TMO])) break; if (_sp > XB_SPIN_CAP) { atomicAdd(&(bar)[XB_TMO], 1u); break; } } } } while (0)
struct XcdBarrier { unsigned* bar; unsigned x; volatile LAS unsigned* st; };
__device__ __forceinline__ XcdBarrier xcd_barrier_post(unsigned* bar, volatile LAS unsigned* st) {
    XcdBarrier b; b.bar = bar; b.x = (unsigned)__builtin_amdgcn_readfirstlane((int)xb_xcc_id()); b.st = st;
    if (threadIdx.x == 0) (void)xb_add(&bar[XB_XCNT(b.x)], 1u);
    return b;
}
__device__ __forceinline__ void xcd_barrier_complete(unsigned* bar, unsigned x, unsigned& nloc, unsigned& nx) {
    const unsigned G = gridDim.x * gridDim.y * gridDim.z;
    unsigned sum, cnt, mine, sp = 0u;
    for (;;) {
        sum = 0u; cnt = 0u; mine = 0u;
#pragma unroll
        for (unsigned j = 0; j < 16; ++j) { const unsigned c = xb_ld(&bar[XB_XCNT(j)]); sum += c; cnt += (c > 0u) ? 1u : 0u; mine = (j == x) ? c : mine; }
        if (sum == G) break;
        __builtin_amdgcn_s_sleep(1);
        if ((++sp & 255u) == 0u) { if (xb_ld(&bar[XB_TMO])) break; if (sp > XB_SPIN_CAP) { atomicAdd(&bar[XB_TMO], 1u); break; } }
    }
    nloc = mine > 0u ? mine : 1u; nx = cnt > 0u ? cnt : 1u;
}
__device__ __forceinline__ void xcd_barrier(const XcdBarrier& b) {
    asm volatile("s_waitcnt vmcnt(0)" ::: "memory");
    __syncthreads();
    if (threadIdx.x == 0) {
        unsigned* bar = b.bar;
        __builtin_amdgcn_s_waitcnt(0);
        unsigned bx = b.x; asm volatile("" : "+s"(bx));
        unsigned nloc = b.st[0], nx = b.st[1];
        if (nloc == 0u) { xcd_barrier_complete(bar, bx, nloc, nx); b.st[0] = nloc; b.st[1] = nx; }
        const unsigned old = xb_add(&bar[XB_XSUB(bx)], 1u);
        const unsigned gen = old / nloc;
        if (old + 1u == (gen + 1u) * nloc) {
            __builtin_amdgcn_fence(__ATOMIC_RELEASE, "agent");
            asm volatile("s_waitcnt vmcnt(0)" ::: "memory");
            const unsigned og = xb_add(&bar[XB_TOP], 1u);
            const unsigned tg = og / nx;
            if (og + 1u == (tg + 1u) * nx) xb_add(&bar[XB_TOPGEN], 1u);
            else XB_SPIN(xb_ld(&bar[XB_TOPGEN]) == tg, bar);
            __builtin_amdgcn_fence(__ATOMIC_ACQUIRE, "agent");
            xb_add(&bar[XB_XGEN(bx)], 1u);
            asm volatile("s_waitcnt vmcnt(0)" ::: "memory");
        } else {
            XB_SPIN(xb_ld(&bar[XB_XGEN(bx)]) == gen, bar);
            __builtin_amdgcn_fence(__ATOMIC_ACQUIRE, "agent");
            asm volatile("s_waitcnt vmcnt(0)" ::: "memory");
        }
    }
    __syncthreads();
}

__device__ __forceinline__ unsigned f2bf(float f) { unsigned u = __builtin_bit_cast(unsigned, f); return (u + 0x7fffu + ((u >> 16) & 1u)) >> 16; }
__device__ __forceinline__ unsigned pk2(float lo, float hi) { return f2bf(lo) | (f2bf(hi) << 16); }
__device__ __forceinline__ void p0_transpose_item(const float* W, const float* gain, int K, int N, bf16_t* WT, int row_off, LAS float* scr, int item, int lane) {
    const int nblk = N / 64, kb = item / nblk, nb = item % nblk, k0 = 64 * kb, n0 = 64 * nb;
    const int ksub = lane >> 4, n4 = (lane & 15) * 4;
    f32x4 v[16];
#pragma unroll
    for (int i = 0; i < 16; ++i) v[i] = *(const f32x4*)(W + (size_t)(k0 + 4 * i + ksub) * N + n0 + n4);
#pragma unroll
    for (int i = 0; i < 16; ++i) { const int kk = 4 * i + ksub; const float gsc = gain ? gain[k0 + kk] : 1.0f; LAS float* d = scr + kk * 65 + n4;
        d[0] = v[i][0] * gsc; d[1] = v[i][1] * gsc; d[2] = v[i][2] * gsc; d[3] = v[i][3] * gsc; }
    asm volatile("s_waitcnt lgkmcnt(0)" ::: "memory");
    const int c = lane & 7;
#pragma unroll
    for (int j = 0; j < 8; ++j) { const int n = (lane >> 3) + 8 * j; const LAS float* s = scr + (8 * c) * 65 + n;
        u32x4 o; o.x = pk2(s[0 * 65], s[1 * 65]); o.y = pk2(s[2 * 65], s[3 * 65]); o.z = pk2(s[4 * 65], s[5 * 65]); o.w = pk2(s[6 * 65], s[7 * 65]);
        *(u32x4*)(WT + (size_t)(row_off + n0 + n) * K + k0 + 8 * c) = o; }
    asm volatile("s_waitcnt lgkmcnt(0)" ::: "memory");
}

struct Params {
    const float* x_prompt; const float* x_sample; const float* cache_conv; const float* cache_k; const float* cache_v;
    const float* norm_a; const float* w_in_a; const float* conv_w; const float* w_out_a; const float* norm_kv; const float* w_kv;
    const float* norm_b; const float* w_q; const float* w_o; const float* sinks; const float* norm_ffn; const float* w_gu; const float* w_down; const float* norm_final;
    float* out; unsigned char* ws;
};

__device__ __forceinline__ void convert_set(const Params& P, LAS unsigned char* lds, int wid, int lane, int set, int w, int nw) {
    asm volatile("" : "+v"(lane));
    LAS float* scr = (LAS float*)(lds + wid * LDS_P0SCR);
    unsigned char* ws = P.ws;
    constexpr int I_IN = 16 * 48, I_SQ = 16 * 16, I_GU = 16 * 88, I_DN = 44 * 16, I_KV = 16 * 8;
    const int n_head = (set < 2) ? (I_IN + I_SQ) : ((set == 2 ? I_KV : 0) + 2 * I_SQ);
    const int nitems = n_head + I_GU + I_DN;
    for (int it = w; it < nitems; it += nw) {
        int r = it;
        if (r < n_head) {
            if (set < 2) {
                if (r < I_IN) { p0_transpose_item(P.w_in_a + (size_t)set * 1024 * 3072, P.norm_a + set * 1024, 1024, 3072, (bf16_t*)(ws + WS_WIN + set * SZ_WIN), 0, scr, r, lane); continue; } r -= I_IN;
                p0_transpose_item(P.w_out_a + (size_t)set * 1024 * 1024, nullptr, 1024, 1024, (bf16_t*)(ws + WS_WOUT + set * SZ_SQ), 0, scr, r, lane); continue;
            } else {
                const int a = set - 2;
                if (set == 2) { if (r < I_KV) { p0_transpose_item(P.w_kv, P.norm_kv, 1024, 512, (bf16_t*)(ws + WS_WKVQ), 0, scr, r, lane); continue; } r -= I_KV; }
                if (r < I_SQ) { p0_transpose_item(P.w_q + (size_t)a * 1024 * 1024, P.norm_b + a * 1024, 1024, 1024, (bf16_t*)(ws + (a == 0 ? WS_WKVQ : WS_WQ1)), a == 0 ? 512 : 0, scr, r, lane); continue; } r -= I_SQ;
                p0_transpose_item(P.w_o + (size_t)a * 1024 * 1024, nullptr, 1024, 1024, (bf16_t*)(ws + WS_WO + a * SZ_SQ), 0, scr, r, lane); continue;
            }
        }
        r -= n_head;
        if (r < I_GU) { p0_transpose_item(P.w_gu + (size_t)set * 1024 * 5632, P.norm_ffn + set * 1024, 1024, 5632, (bf16_t*)(ws + WS_WGU + set * SZ_WGU), 0, scr, r, lane); continue; } r -= I_GU;
        p0_transpose_item(P.w_down + (size_t)set * 2816 * 1024, nullptr, 2816, 1024, (bf16_t*)(ws + WS_WDN + set * SZ_WDN), 0, scr, r, lane);
    }
}

__device__ __forceinline__ void p0_prologue(const Params& P, LAS unsigned char* lds, int wid, int lane) {
    asm volatile("" : "+v"(lane));
    const int gw = blockIdx.x * 8 + wid, NGW = gridDim.x * 8;
    unsigned char* ws = P.ws;
    convert_set(P, lds, wid, lane, 0, gw, NGW);
    bf16_t* xb = (bf16_t*)(ws + WS_XB); float* ssq = (float*)(ws + WS_SSQ);
    for (int row = gw; row < MT; row += NGW) {
        const float* src = (row < MP) ? P.x_prompt + (size_t)row * D : P.x_sample + (size_t)(row - MP) * D;
        float ss = 0.f;
#pragma unroll
        for (int j = 0; j < 4; ++j) { const f32x4 v = *((const f32x4*)src + lane + 64 * j);
            ss += (v[0] * v[0] + v[1] * v[1]) + (v[2] * v[2] + v[3] * v[3]); st_bf4(xb + (size_t)row * D + 4 * (lane + 64 * j), v); }
#pragma unroll
        for (int o = 1; o < 64; o <<= 1) ss += __shfl_xor(ss, o);
        if (lane < 16) ssq[(size_t)row * 16 + lane] = (lane == 0) ? ss : 0.f;
    }
    int gt_ = threadIdx.x; asm volatile("" : "+v"(gt_)); const int gt = blockIdx.x * 512 + gt_, NGT = gridDim.x * 512;
    float* cosT = (float*)(ws + WS_COS); float* sinT = (float*)(ws + WS_SIN);
    for (int idx = gt; idx < 8193 * 32; idx += NGT) {
        const int pos = idx >> 5, i = idx & 31;
        const float freq = (float)exp2((double)(-i) * (13.287712379549449 / 32.0));
        const float ang = (float)pos * freq;
        double rev = (double)ang * 0.15915494309189535; rev = rev - rint(rev);
        const float rf = (float)rev;
        cosT[idx] = __builtin_amdgcn_cosf(rf); sinT[idx] = __builtin_amdgcn_sinf(rf);
    }
    for (int idx = gt; idx < 128 * 127 * 64; idx += NGT) {
        const int n = idx / 8128, r = idx % 8128;
        const f32x4 kv = *((const f32x4*)(P.cache_k + (size_t)n * 32768 + 256) + r), vv = *((const f32x4*)(P.cache_v + (size_t)n * 32768 + 256) + r);
        *((f32x4*)(P.out + OUT_KWS + (size_t)n * 32768) + r) = kv; *((f32x4*)(P.out + OUT_VWS + (size_t)n * 32768) + r) = vv;
    }
    for (int idx = gt; idx < 2 * 128 * 256; idx += NGT) {
        const int ln = idx >> 8, r = idx & 255;
        *((f32x4*)(P.out + OUT_CONVS + (size_t)ln * 2048) + r) = *((const f32x4*)(P.cache_conv + (size_t)ln * 2048 + 1024) + r);
    }
}

__device__ __forceinline__ int crow(int r, int hi) { return (r & 3) + 8 * (r >> 2) + 4 * hi; }
constexpr int KSTR = 144, VSTR = 520, LDS_VT = 256 * KSTR;

__device__ __forceinline__ void attn_prompt_unit(LAS unsigned char* lds, int b, int qblk, int kvh, const bf16_t* qb, const bf16_t* kb, const bf16_t* vT, bf16_t* ob, const float* sinks, int wid, int lane) {
    int tid_ = threadIdx.x; asm volatile("" : "+v"(tid_)); const int tid = tid_; lane = tid & 63;
    __syncthreads();
    const long rowbase = (long)b * SEQ + (long)(qblk - 1) * WIN;
#pragma unroll
    for (int i = 0; i < 4; ++i) { const int c = tid + i * 512, key = c >> 3, part = c & 7;
        if (qblk > 0 || key >= WIN) { const u32x4 v = *(const u32x4*)(kb + (size_t)(rowbase + key) * 256 + kvh * 64 + part * 8); *(LAS u32x4*)(lds + key * KSTR + part * 16) = v; } }
#pragma unroll
    for (int i = 0; i < 4; ++i) { const int c = tid + i * 512, d = c >> 5, part = c & 31;
        if (qblk > 0 || part >= 16) { const u32x4 v = *(const u32x4*)(vT + (size_t)((b * 4 + kvh) * 64 + d) * SEQ + (long)(qblk - 1) * WIN + part * 8);
            LAS unsigned* dst = (LAS unsigned*)(lds + LDS_VT + d * VSTR + part * 16); dst[0] = v.x; dst[1] = v.y; dst[2] = v.z; dst[3] = v.w; } }
    const int ql = lane & 31, hi = lane >> 5, head = kvh * 4 + (wid >> 1);
    bf16x8 qfa[2][4];
#pragma unroll
    for (int i = 0; i < 2; ++i)
#pragma unroll
        for (int s = 0; s < 4; ++s) qfa[i][s] = *(const bf16x8*)(qb + ((size_t)b * SEQ + (size_t)qblk * WIN + (wid & 1) * 64 + i * 32 + ql) * D + head * 64 + s * 16 + hi * 8);
    const float sink2 = sinks[head] * LOG2E;
    __syncthreads();
#pragma unroll
    for (int i = 0; i < 2; ++i) {
        const int r0 = (wid & 1) * 64 + i * 32, kb0 = r0 >> 5;
        const size_t qrow = (size_t)b * SEQ + (size_t)qblk * WIN + r0 + ql;
        bf16x8 qf[4];
#pragma unroll
        for (int s = 0; s < 4; ++s) qf[s] = qfa[i][s];
        f32x16 S[5];
#pragma unroll
        for (int jb = 0; jb < 5; ++jb) {
            const int kblk = kb0 + jb;
            f32x16 a;
#pragma unroll
            for (int r = 0; r < 16; ++r) a[r] = 0.f;
            if (qblk > 0 || kblk >= 4) {
#pragma unroll
                for (int s = 0; s < 4; ++s) { const bf16x8 kf = *(const LAS bf16x8*)(lds + (kblk * 32 + ql) * KSTR + (s * 16 + hi * 8) * 2);
                    a = __builtin_amdgcn_mfma_f32_32x32x16_bf16(kf, qf[s], a, 0, 0, 0); }
            } else {
#pragma unroll
                for (int r = 0; r < 16; ++r) a[r] = -INFINITY;
            }
            S[jb] = a;
        }
#pragma unroll
        for (int r = 0; r < 16; ++r) { const int kk = crow(r, hi); if (!(kk > ql)) S[0][r] = -INFINITY; if (!(kk <= ql)) S[4][r] = -INFINITY; }
        float mx = sink2;
#pragma unroll
        for (int jb = 0; jb < 5; ++jb)
#pragma unroll
            for (int r = 0; r < 16; ++r) mx = fmaxf(mx, S[jb][r]);
        mx = fmaxf(mx, __shfl_xor(mx, 32));
        float sum = 0.f;
#pragma unroll
        for (int jb = 0; jb < 5; ++jb)
#pragma unroll
            for (int r = 0; r < 16; ++r) { const float p = __builtin_amdgcn_exp2f(S[jb][r] - mx); S[jb][r] = p; sum += p; }
        sum += __shfl_xor(sum, 32);
        const float rinv = 1.0f / (sum + __builtin_amdgcn_exp2f(sink2 - mx));
        f32x16 o0, o1;
#pragma unroll
        for (int r = 0; r < 16; ++r) { o0[r] = 0.f; o1[r] = 0.f; }
#pragma unroll
        for (int jb = 0; jb < 5; ++jb) {
            const int kblk = kb0 + jb;
            if (qblk > 0 || kblk >= 4) {
#pragma unroll
                for (int s2 = 0; s2 < 2; ++s2) {
                    u32x4 pw; pw.x = cvt_pk_bf16(S[jb][8 * s2 + 0], S[jb][8 * s2 + 1]); pw.y = cvt_pk_bf16(S[jb][8 * s2 + 2], S[jb][8 * s2 + 3]);
                    pw.z = cvt_pk_bf16(S[jb][8 * s2 + 4], S[jb][8 * s2 + 5]); pw.w = cvt_pk_bf16(S[jb][8 * s2 + 6], S[jb][8 * s2 + 7]);
                    const bf16x8 pf = __builtin_bit_cast(bf16x8, pw);
                    const int keybase = kblk * 32 + 16 * s2 + 4 * hi;
#pragma unroll
                    for (int dblk = 0; dblk < 2; ++dblk) {
                        const LAS unsigned char* vp = lds + LDS_VT + (dblk * 32 + ql) * VSTR + keybase * 2;
                        const u32x2 lo = *(const LAS u32x2*)vp, hh = *(const LAS u32x2*)(vp + 16);
                        const u32x4 vw = (u32x4){lo.x, lo.y, hh.x, hh.y}; const bf16x8 vf = __builtin_bit_cast(bf16x8, vw);
                        if (dblk == 0) o0 = __builtin_amdgcn_mfma_f32_32x32x16_bf16(vf, pf, o0, 0, 0, 0);
                        else o1 = __builtin_amdgcn_mfma_f32_32x32x16_bf16(vf, pf, o1, 0, 0, 0);
                    }
                }
            }
        }
        bf16_t* op = ob + qrow * D + head * 64;
#pragma unroll
        for (int dblk = 0; dblk < 2; ++dblk) {
            u32x2 ch[4];
#pragma unroll
            for (int g = 0; g < 4; ++g) { const f32x16& oo = dblk == 0 ? o0 : o1; ch[g].x = cvt_pk_bf16(oo[4 * g] * rinv, oo[4 * g + 1] * rinv); ch[g].y = cvt_pk_bf16(oo[4 * g + 2] * rinv, oo[4 * g + 3] * rinv); }
#pragma unroll
            for (int gp = 0; gp < 2; ++gp) {
                const u32x2 give = hi == 0 ? ch[2 * gp + 1] : ch[2 * gp];
                u32x2 got; got.x = (unsigned)__shfl_xor((int)give.x, 32); got.y = (unsigned)__shfl_xor((int)give.y, 32);
                const int g = 2 * gp + hi; const u32x2 mine = hi == 0 ? ch[2 * gp] : ch[2 * gp + 1];
                u32x4 p; if (hi == 0) { p.x = mine.x; p.y = mine.y; p.z = got.x; p.w = got.y; } else { p.x = got.x; p.y = got.y; p.z = mine.x; p.w = mine.y; }
                *(u32x4*)(op + dblk * 32 + 8 * g) = p;
            }
        }
    }
}

__device__ __forceinline__ void attn_sample_task(int n, int head, const bf16_t* qb, const float* kws, const float* vws, bf16_t* ob, const float* sinks, int lane) {
    asm volatile("" : "+v"(lane));
    const int kvh = head >> 2; const size_t qrow = (size_t)MP + n;
    const float sink2 = sinks[head] * LOG2E;
    const bf16_t* qp = qb + qrow * D + head * 64;
    const float* k0 = kws + ((size_t)(n * WIN + lane) * 4 + kvh) * 64; const float* k1 = k0 + (size_t)64 * 256;
    const int kq = lane >> 4, dq = lane & 15;
    const float* vp = vws + ((size_t)(n * WIN + kq) * 4 + kvh) * 64 + 4 * dq;
    f32x4 vv[32];
#pragma unroll
    for (int i = 0; i < 32; ++i) vv[i] = *(const f32x4*)(vp + (size_t)i * 1024);
    float s0 = 0.f, s1 = 0.f;
#pragma unroll
    for (int c = 0; c < 8; ++c) {
        const u32x4 qw = *(const u32x4*)(qp + c * 8);
        const float q0 = bf_lo(qw.x), q1 = bf_hi(qw.x), q2 = bf_lo(qw.y), q3 = bf_hi(qw.y), q4 = bf_lo(qw.z), q5 = bf_hi(qw.z), q6 = bf_lo(qw.w), q7 = bf_hi(qw.w);
        const f32x4 a0 = *(const f32x4*)(k0 + c * 8), a1 = *(const f32x4*)(k0 + c * 8 + 4), b0 = *(const f32x4*)(k1 + c * 8), b1 = *(const f32x4*)(k1 + c * 8 + 4);
        s0 += q0 * a0[0] + q1 * a0[1] + q2 * a0[2] + q3 * a0[3] + q4 * a1[0] + q5 * a1[1] + q6 * a1[2] + q7 * a1[3];
        s1 += q0 * b0[0] + q1 * b0[1] + q2 * b0[2] + q3 * b0[3] + q4 * b1[0] + q5 * b1[1] + q6 * b1[2] + q7 * b1[3];
    }
    float mx = fmaxf(fmaxf(s0, s1), sink2);
#pragma unroll
    for (int o = 1; o < 64; o <<= 1) mx = fmaxf(mx, __shfl_xor(mx, o));
    const float p0 = __builtin_amdgcn_exp2f(s0 - mx), p1 = __builtin_amdgcn_exp2f(s1 - mx);
    float sum = p0 + p1;
#pragma unroll
    for (int o = 1; o < 64; o <<= 1) sum += __shfl_xor(sum, o);
    const float rinv = 1.0f / (sum + __builtin_amdgcn_exp2f(sink2 - mx));
    f32x4 o4 = (f32x4){0.f, 0.f, 0.f, 0.f};
#pragma unroll
    for (int i = 0; i < 32; ++i) { const int key = 4 * i + kq; const float p = __shfl((i < 16) ? p0 : p1, key & 63); o4 += vv[i] * p; }
#pragma unroll
    for (int e = 0; e < 4; ++e) { o4[e] += __shfl_xor(o4[e], 16); o4[e] += __shfl_xor(o4[e], 32); }
    if (kq == 0) st_bf4(ob + qrow * D + head * 64 + 4 * dq, o4 * rinv);
}

__device__ __forceinline__ void attn_phase(LAS unsigned char* lds, const Params& P, int layer, int wid, int lane) {
    unsigned char* ws = P.ws;
    const bf16_t* qb = (const bf16_t*)(ws + WS_ACT); bf16_t* ob = (bf16_t*)(ws + WS_ACT + SZ_ACT1K);
    const bf16_t* kb = (const bf16_t*)(ws + WS_K); const bf16_t* vT = (const bf16_t*)(ws + WS_VT);
    const float* sinks = P.sinks + layer * 16;
    for (int task = blockIdx.x * 8 + wid; task < MS * 16; task += gridDim.x * 8)
        attn_sample_task(task >> 4, task & 15, qb, P.out + OUT_KWS, P.out + OUT_VWS, ob, sinks, lane);
    for (int uidx = blockIdx.x; uidx < 512; uidx += gridDim.x) {
        const int kvh = uidx & 3, bq = uidx >> 2, b = bq >> 6, qblk = bq & 63;
        attn_prompt_unit(lds, b, qblk, kvh, qb, kb, vT, ob, sinks, wid, lane);
    }
    __syncthreads();
}

__global__ void __launch_bounds__(512, 2) yoco_fwd(Params P) {
    extern __shared__ __attribute__((aligned(16))) unsigned char lds_raw[];
    LAS unsigned char* lds = (LAS unsigned char*)lds_raw;
    cg::grid_group grid = cg::this_grid();
    const int tid = threadIdx.x, lane0 = tid & 63, wid_first = __builtin_amdgcn_readfirstlane(tid >> 6);
    const int G0 = gridDim.x, bid0 = blockIdx.x, wid0 = wid_first;
    unsigned char* ws = P.ws;
    float* x = P.out + OUT_Y;
    bf16_t* xb = (bf16_t*)(ws + WS_XB);
    float* ssq = (float*)(ws + WS_SSQ);
    bf16_t* actb = (bf16_t*)(ws + WS_ACT);
    bf16_t* ub = (bf16_t*)(ws + WS_ACT);
    bf16_t* zb = (bf16_t*)(ws + WS_ACT + SZ_ACT1K);
    LAS float* linv = (LAS float*)(lds + LDS_LINV);
    constexpr int NM = MP / 256;

    int G = G0, bid = bid0, wid = wid0;
#define MINI_ASSIGN(nunits) const int rem_ = (nunits) % G; const int nblk_ = G - rem_; const int bi_ = (bid >= rem_) ? bid - rem_ : (1 << 28)
    unsigned* barw = (unsigned*)(ws + WS_BAR);
    volatile LAS unsigned* barst = (volatile LAS unsigned*)(lds + LDS_BARST);
    if (tid < 2) barst[tid] = 0u;
    __syncthreads();
    const XcdBarrier xbar = xcd_barrier_post(barw, barst);
    if (P.out == nullptr) grid.sync();
    for (int rep = 0; rep < REP_P0; ++rep) p0_prologue(P, lds, wid, lane0);
#define GRID_BAR() xcd_barrier(xbar)
    GRID_BAR();
    for (int rep = 0; rep < EXTRA_SYNCS; ++rep) GRID_BAR();

    for (int li = 0; li < 4; ++li) {
        int G = G0, bid = bid0, wid = wid0; asm volatile("" : "+s"(G), "+s"(bid), "+s"(wid));
        if (li < 2) {
            const int l = li;
            const bf16_t* WinT = (const bf16_t*)(ws + WS_WIN + l * SZ_WIN);
            {
                pg8::Gemm g{xb, WinT + (size_t)1024 * 1024, NM, 8, 1024, 128, 1024}; pg8::StaticOrder S; S.init(NM, 8, G, bid);
                EpiU E{linv, ub, ssq, P.out + OUT_CONVP + (size_t)l * 4096, P.out + OUT_CONVS + (size_t)l * 128 * 2048, zb, P.conv_w + (size_t)l * 3 * 1024, P.cache_conv + (size_t)l * 128 * 2048};
                for (int rep = 0; rep < REP_U; ++rep) pg8::gemm_phase<EpiU>(lds, g, S, E);
                { MINI_ASSIGN(NM * 8); mini_phase<EpiU, 3>(lds, g.A, g.Bt, 1024, 1024, -1024, 32, 32, E, ssq, bi_, nblk_); }
            }
            GRID_BAR();
            {
                pg8::Gemm g{xb, WinT, NM, 4, 1024, 256, 128}; pg8::StaticOrder S; S.init(NM, 4, G, bid);
                EpiZ E{linv, zb, ub, ssq, P.conv_w + (size_t)l * 3 * 1024, P.cache_conv + (size_t)l * 128 * 2048};
                pg8::gemm_phase<EpiZ>(lds, g, S, E);
            }
            GRID_BAR();
            {
                pg8::Gemm g{zb, (const bf16_t*)(ws + WS_WOUT + l * SZ_SQ), NM, 4, 1024, 256, 128}; pg8::StaticOrder S; S.init(NM, 4, G, bid);
                EpiX E{xb, ssq};
                pg8::gemm_phase<EpiX>(lds, g, S, E);
                { MINI_ASSIGN(NM * 4); mini_phase<EpiX, 2>(lds, g.A, g.Bt, 1024, 32, 0, 64, 16, E, ssq, bi_, nblk_); }
            }
            GRID_BAR();
        } else {
            const int l = li - 2;
            if (l == 0) {
                pg8::Gemm g{xb, (const bf16_t*)(ws + WS_WKVQ), NM + 1, 6, 1024, 256, 32}; pg8::StaticOrder S; S.init(NM + 1, 6, G, bid);
                EpiKVQ E{linv, ssq, (const float*)(ws + WS_COS), (const float*)(ws + WS_SIN), (bf16_t*)(ws + WS_K), (bf16_t*)(ws + WS_VT), ub, P.out, 0, 1, 2, lds + LDS_VSCR};
                pg8::gemm_phase<EpiKVQ>(lds, g, S, E);
            } else {
                pg8::Gemm g{xb, (const bf16_t*)(ws + WS_WQ1), NM, 4, 1024, 256, 32}; pg8::StaticOrder S; S.init(NM, 4, G, bid);
                EpiKVQ E{linv, ssq, (const float*)(ws + WS_COS), (const float*)(ws + WS_SIN), (bf16_t*)(ws + WS_K), (bf16_t*)(ws + WS_VT), ub, P.out, -1, -1, 0, lds + LDS_VSCR};
                pg8::gemm_phase<EpiKVQ>(lds, g, S, E);
                { MINI_ASSIGN(NM * 4); mini_phase<EpiKVQ, 2>(lds, g.A, g.Bt, 1024, 32, 0, 64, 16, E, ssq, bi_, nblk_); }
            }
            GRID_BAR();
            for (int rep = 0; rep < REP_ATT; ++rep) attn_phase(lds, P, l, wid, lane0);
            GRID_BAR();
            {
                pg8::Gemm g{zb, (const bf16_t*)(ws + WS_WO + l * SZ_SQ), NM, 4, 1024, 256, 128}; pg8::StaticOrder S; S.init(NM, 4, G, bid);
                EpiX E{xb, ssq};
                pg8::gemm_phase<EpiX>(lds, g, S, E);
                { MINI_ASSIGN(NM * 4); mini_phase<EpiX, 2>(lds, g.A, g.Bt, 1024, 32, 0, 64, 16, E, ssq, bi_, nblk_); }
            }
            GRID_BAR();
        }
        {
            pg8::Gemm g{xb, (const bf16_t*)(ws + WS_WGU + li * SZ_WGU), NM + 1, 22, 1024, 128, 2816}; pg8::StaticOrder S; S.init(NM + 1, 22, G, bid);
            EpiAct E{linv, actb, ssq};
            for (int rep = 0; rep < REP_ACT; ++rep) pg8::gemm_phase<EpiAct>(lds, g, S, E);
            if (li < 3) { const int rem_ = ((NM + 1) * 22) % G;
                if (bid >= rem_) convert_set(P, lds, wid, lane0, li + 1, (bid - rem_) * 8 + wid, (G - rem_) * 8); }
        }
        GRID_BAR();
        {
            pg8::Gemm g{actb, (const bf16_t*)(ws + WS_WDN + li * SZ_WDN), NM, 4, 2816, 256, 128}; pg8::StaticOrder S; S.init(NM, 4, G, bid);
            EpiX E{xb, ssq};
            pg8::gemm_phase<EpiX>(lds, g, S, E);
            { MINI_ASSIGN(NM * 4); mini_phase<EpiX, 2>(lds, g.A, g.Bt, 2816, 32, 0, 64, 16, E, ssq, bi_, nblk_); }
        }
        GRID_BAR();
    }
    {
        const int gw = bid * 8 + wid, NGW = G * 8; int lane = lane0; asm volatile("" : "+v"(lane));
        for (int row = gw; row < MT; row += NGW) {
            const f32x4* p = (const f32x4*)(ssq + (size_t)row * 16);
            const f32x4 a = p[0], b = p[1], c = p[2], d = p[3];
            const float s = ((a[0] + a[1]) + (a[2] + a[3])) + ((b[0] + b[1]) + (b[2] + b[3])) + ((c[0] + c[1]) + (c[2] + c[3])) + ((d[0] + d[1]) + (d[2] + d[3]));
            const float iv = __builtin_amdgcn_rsqf(s * (1.0f / 1024.0f) + EPS);
#pragma unroll
            for (int j = 0; j < 4; ++j) { const int c = 4 * (lane + 64 * j); const f32x4 gv = *(const f32x4*)(P.norm_final + c);
                *(f32x4*)(x + (size_t)row * D + c) = ld_bf4(xb + (size_t)row * D + c) * iv * gv; }
        }
    }
}

extern "C" void kernel_launch(void* const* d_in, const int* in_sizes, int n_in, void* d_out, int out_size, void* d_ws, size_t ws_size, hipStream_t stream) {
    static int grid_blocks = 0;
    if (grid_blocks == 0) {
        if (n_in != 19 || (size_t)out_size != OUT_TOTAL || ws_size < WS_END) { fprintf(stderr, "kernel_launch: unexpected shapes (n_in %d out %d ws %zu need %zu)\n", n_in, out_size, ws_size, (size_t)WS_END); grid_blocks = -1; return; }
        int dev = 0, cus = 0, per_cu = 0;
        hipGetDevice(&dev);
        hipDeviceGetAttribute(&cus, hipDeviceAttributeMultiprocessorCount, dev);
        hipFuncSetAttribute((const void*)yoco_fwd, hipFuncAttributeMaxDynamicSharedMemorySize, LDS_BYTES);
        hipOccupancyMaxActiveBlocksPerMultiprocessor(&per_cu, (const void*)yoco_fwd, 512, LDS_BYTES);
        if (per_cu < 1) { fprintf(stderr, "kernel_launch: occupancy query says %d blocks per CU\n", per_cu); per_cu = 1; }
        (void)hipGetLastError();
        grid_blocks = cus * per_cu;
    }
    if (grid_blocks < 0) return;
    Params p{};
    p.x_prompt = (const float*)d_in[0]; p.x_sample = (const float*)d_in[1]; p.cache_conv = (const float*)d_in[2]; p.cache_k = (const float*)d_in[3]; p.cache_v = (const float*)d_in[4];
    p.norm_a = (const float*)d_in[5]; p.w_in_a = (const float*)d_in[6]; p.conv_w = (const float*)d_in[7]; p.w_out_a = (const float*)d_in[8]; p.norm_kv = (const float*)d_in[9]; p.w_kv = (const float*)d_in[10];
    p.norm_b = (const float*)d_in[11]; p.w_q = (const float*)d_in[12]; p.w_o = (const float*)d_in[13]; p.sinks = (const float*)d_in[14]; p.norm_ffn = (const float*)d_in[15]; p.w_gu = (const float*)d_in[16]; p.w_down = (const float*)d_in[17]; p.norm_final = (const float*)d_in[18];
    p.out = (float*)d_out; p.ws = (unsigned char*)d_ws;
    if (hipMemsetAsync((unsigned char*)d_ws + WS_BAR, 0, 16384, stream) != hipSuccess) { fprintf(stderr, "kernel_launch: hipMemsetAsync of the barrier words failed\n"); return; }
    void* args[] = {&p};
    hipError_t e = hipLaunchCooperativeKernel((const void*)yoco_fwd, dim3(grid_blocks), dim3(512), args, LDS_BYTES, stream);
    if (e != hipSuccess) fprintf(stderr, "cooperative launch failed: %s (grid %d)\n", hipGetErrorString(e), grid_blocks);
}
```
